# Optimizing an MI355X kernel written in HIP

```python
import jax
import jax.numpy as jnp
from jax import lax
import numpy as np

D_MODEL = 1024
BATCH = 4
SEQ = 8192
DEPTH = 4

CHUNK = 64
N_MIXERS = 3
PLE_DIM = 256
EPS = 1e-6

HG_HEADS = D_MODEL // 128
HG_DK = D_MODEL // HG_HEADS
HG_DV = D_MODEL // HG_HEADS

FOX_HEADS = D_MODEL // 64
FOX_HD = D_MODEL // FOX_HEADS
Q_BLOCK = 128

RG_WIDTH = D_MODEL
RG_BLOCKS = 4
RG_BW = RG_WIDTH // RG_BLOCKS
CONV_W = 4
RG_C = 8.0

N_EXPERTS = 32
TOP_K = 4
D_EXPERT = D_MODEL
SWIGLU_LIMIT = 7.0
SWIGLU_ALPHA = 1.702
EXPERT_BLOCK = 128

N_HG = (DEPTH + 2) // 3
N_FOX = (DEPTH + 1) // 3
N_RG = DEPTH // 3

kernel_name = 'hybrid_hgrn2_fox_rglru_moe'


def rmsnorm(x, g):
    xf = x.astype(jnp.float32)
    y = xf * lax.rsqrt(jnp.mean(xf * xf, axis=-1, keepdims=True) + EPS)
    return (y * g.astype(jnp.float32)).astype(x.dtype)


def hgrn2_mixer(xn, w_in, w_out, g_norm, lb):
    b, s, _ = xn.shape
    nc = s // CHUNK
    q, z, v, g = jnp.split(xn @ w_in, 4, axis=-1)
    q = jax.nn.silu(q.astype(jnp.float32)) * HG_DK ** -0.5
    z = z.astype(jnp.float32)
    lbf = lb.astype(jnp.float32)
    log_f = jnp.logaddexp(jnp.log(lbf), jnp.log1p(-lbf) + jax.nn.log_sigmoid(z))
    k = (1.0 - lbf) * jax.nn.sigmoid(-z)

    def to_chunks(t, dh):
        return t.reshape(b, nc, CHUNK, HG_HEADS, dh).transpose(1, 0, 3, 2, 4)

    qc, kc, lfc = to_chunks(q, HG_DK), to_chunks(k, HG_DK), to_chunks(log_f, HG_DK)
    vc = to_chunks(v.astype(jnp.float32), HG_DV)
    causal = jnp.tril(jnp.ones((CHUNK, CHUNK), dtype=bool))

    def step(state, inp):
        qi, ki, vi, lfi = inp
        cum = jnp.cumsum(lfi, axis=2)
        diff = cum[:, :, :, None, :] - cum[:, :, None, :, :]
        decay = jnp.exp(jnp.where(causal[:, :, None], diff, -jnp.inf))
        scores = jnp.einsum('bhtd,bhtsd,bhsd->bhts', qi, decay, ki)
        o = (jnp.einsum('bhts,bhsv->bhtv', scores, vi)
             + jnp.einsum('bhtd,bhdv->bhtv', qi * jnp.exp(cum), state))
        last = cum[:, :, -1:, :]
        state = (jnp.exp(last[:, :, 0, :, None]) * state
                 + jnp.einsum('bhsd,bhsv->bhdv', ki * jnp.exp(last - cum), vi))
        return state, o

    state0 = jnp.zeros((b, HG_HEADS, HG_DK, HG_DV), jnp.float32)
    _, o = lax.scan(step, state0, (qc, kc, vc, lfc))
    o = o.transpose(1, 0, 3, 2, 4).reshape(b, s, HG_HEADS, HG_DV)
    o = rmsnorm(o, g_norm) * jax.nn.silu(g.astype(jnp.float32)).reshape(b, s, HG_HEADS, HG_DV)
    return o.reshape(b, s, D_MODEL).astype(xn.dtype) @ w_out


def fox_mixer(xn, w_in, f_bias, q_norm, k_norm, w_out):
    b, s, _ = xn.shape
    proj = xn @ w_in
    q, k, v, g = jnp.split(proj[..., :4 * D_MODEL], 4, axis=-1)
    f_logit = (proj[..., 4 * D_MODEL:] + f_bias).astype(jnp.float32)
    q = rmsnorm(q.reshape(b, s, FOX_HEADS, FOX_HD), q_norm).transpose(0, 2, 1, 3)
    k = rmsnorm(k.reshape(b, s, FOX_HEADS, FOX_HD), k_norm).transpose(0, 2, 1, 3)
    v = v.reshape(b, s, FOX_HEADS, FOX_HD).transpose(0, 2, 1, 3)
    cum = jnp.cumsum(jax.nn.log_sigmoid(f_logit), axis=1).transpose(0, 2, 1)
    scale = FOX_HD ** -0.5
    outs = []
    for blk in range(s // Q_BLOCK):
        q0, q1 = blk * Q_BLOCK, (blk + 1) * Q_BLOCK
        logits = jnp.einsum('bhqd,bhkd->bhqk', q[:, :, q0:q1], k[:, :, :q1]).astype(jnp.float32) * scale
        logits = logits + cum[:, :, q0:q1, None] - cum[:, :, None, :q1]
        mask = jnp.arange(q1)[None, :] <= jnp.arange(q0, q1)[:, None]
        probs = jax.nn.softmax(jnp.where(mask, logits, -jnp.inf), axis=-1)
        outs.append(jnp.einsum('bhqk,bhkd->bhqd', probs.astype(v.dtype), v[:, :, :q1]))
    o = jnp.concatenate(outs, axis=2).transpose(0, 2, 1, 3).reshape(b, s, D_MODEL)
    return (o * jax.nn.sigmoid(g)) @ w_out


def _linear_combine(left, right):
    a_l, b_l = left
    a_r, b_r = right
    return a_l * a_r, a_r * b_l + b_r


def rglru_mixer(xn, w_in, conv_w, conv_b, w_a, b_a, w_x, b_x, lam, w_out):
    b, s, _ = xn.shape
    gate, u = jnp.split(xn @ w_in, 2, axis=-1)
    gate = jax.nn.gelu(gate, approximate=True)
    up = jnp.pad(u, ((0, 0), (CONV_W - 1, 0), (0, 0)))
    u = conv_b + up[:, 0:s] * conv_w[0]
    for tap in range(1, CONV_W):
        u = u + up[:, tap:tap + s] * conv_w[tap]
    ub = u.reshape(b, s, RG_BLOCKS, RG_BW)
    r = jax.nn.sigmoid(jnp.einsum('bsnd,nde->bsne', ub, w_a).reshape(b, s, RG_WIDTH) + b_a)
    i = jax.nn.sigmoid(jnp.einsum('bsnd,nde->bsne', ub, w_x).reshape(b, s, RG_WIDTH) + b_x)
    log_a = -RG_C * r.astype(jnp.float32) * jax.nn.softplus(-lam.astype(jnp.float32))
    a = jnp.exp(log_a)
    inp = jnp.sqrt(-jnp.expm1(2.0 * log_a)) * (i * u).astype(jnp.float32)
    _, h = lax.associative_scan(_linear_combine, (a, inp), axis=1)
    return (h.astype(xn.dtype) * gate) @ w_out


def moe(xn, w_r, b_r, w_gu, b_gu, w_dn, b_dn):
    b, s, d = xn.shape
    n = b * s
    xt = xn.reshape(n, d)
    logits = (xt @ w_r + b_r).astype(jnp.float32)
    top_val, top_idx = lax.top_k(logits, TOP_K)
    gates = jax.nn.softmax(top_val, axis=-1).astype(xn.dtype).reshape(-1)
    flat_e = top_idx.reshape(-1)
    order = jnp.argsort(flat_e)
    e_sorted = flat_e[order]
    counts = jnp.bincount(flat_e, length=N_EXPERTS)
    padded = (counts + EXPERT_BLOCK - 1) // EXPERT_BLOCK * EXPERT_BLOCK
    padded_end = jnp.cumsum(padded)
    start = jnp.cumsum(counts) - counts
    dest = padded_end[e_sorted] - padded[e_sorted] + jnp.arange(n * TOP_K) - start[e_sorted]
    n_blocks = -(-(n * TOP_K) // EXPERT_BLOCK) + N_EXPERTS
    cap = n_blocks * EXPERT_BLOCK
    buf_tok = jnp.full((cap,), n, jnp.int32).at[dest].set((order // TOP_K).astype(jnp.int32))
    buf_gate = jnp.zeros((cap,), xn.dtype).at[dest].set(gates[order])
    block_expert = jnp.minimum(
        jnp.searchsorted(padded_end, jnp.arange(n_blocks) * EXPERT_BLOCK, side='right'), N_EXPERTS - 1)
    xp = jnp.concatenate([xt, jnp.zeros((1, d), xt.dtype)], axis=0)

    def expert_block(args):
        tok, gate, e = args
        hgu = xp[tok] @ w_gu[e] + b_gu[e]
        glu, lin = jnp.split(hgu, 2, axis=-1)
        glu = jnp.minimum(glu, SWIGLU_LIMIT)
        lin = jnp.clip(lin, -SWIGLU_LIMIT, SWIGLU_LIMIT)
        act = glu * jax.nn.sigmoid(SWIGLU_ALPHA * glu) * (lin + 1.0)
        return (act @ w_dn[e] + b_dn[e]) * gate[:, None]

    ys = lax.map(expert_block, (buf_tok.reshape(n_blocks, EXPERT_BLOCK),
                                buf_gate.reshape(n_blocks, EXPERT_BLOCK), block_expert))
    out = jnp.zeros((n + 1, d), xn.dtype).at[buf_tok].add(ys.reshape(cap, d))
    return out[:n].reshape(b, s, d)


def setup_inputs(seed: int = 0) -> dict:
    key = jax.random.key(seed)
    ks = iter(jax.random.split(key, 40))
    d = D_MODEL
    out_scale = d ** -0.5 * (2 * DEPTH) ** -0.5

    def nrm(shape, scale):
        return jax.random.normal(next(ks), shape, jnp.float32) * scale

    def gain(shape):
        return 1.0 + nrm(shape, 0.05)

    x = nrm((BATCH, SEQ, d), 1.0)
    p = nrm((DEPTH, BATCH, SEQ, PLE_DIM), 1.0)
    norm_mix = gain((DEPTH, d))
    norm_ffn = gain((DEPTH, d))
    hg_w_in = nrm((N_HG, d, 4 * d), d ** -0.5)
    hg_w_out = nrm((N_HG, d, d), out_scale)
    hg_gnorm = gain((N_HG, HG_DV))
    hg_lb_param = nrm((DEPTH, d), 0.5)
    fox_w_in = nrm((N_FOX, d, 4 * d + FOX_HEADS), d ** -0.5)
    fox_f_bias = 2.0 + nrm((N_FOX, FOX_HEADS), 0.5)
    fox_qnorm = gain((N_FOX, FOX_HD))
    fox_knorm = gain((N_FOX, FOX_HD))
    fox_w_out = nrm((N_FOX, d, d), out_scale)
    rg_w_in = nrm((N_RG, d, 2 * RG_WIDTH), d ** -0.5)
    rg_conv_w = nrm((N_RG, CONV_W, RG_WIDTH), CONV_W ** -0.5)
    rg_conv_b = nrm((N_RG, RG_WIDTH), 0.02)
    rg_wa = nrm((N_RG, RG_BLOCKS, RG_BW, RG_BW), RG_BW ** -0.5)
    rg_ba = nrm((N_RG, RG_WIDTH), 0.1)
    rg_wx = nrm((N_RG, RG_BLOCKS, RG_BW, RG_BW), RG_BW ** -0.5)
    rg_bx = nrm((N_RG, RG_WIDTH), 0.1)
    a_c = jax.random.uniform(next(ks), (N_RG, RG_WIDTH), jnp.float32, 0.9, 0.999)
    sig = a_c ** (1.0 / RG_C)
    rg_lambda = jnp.log(sig) - jnp.log1p(-sig)
    rg_w_out = nrm((N_RG, RG_WIDTH, d), out_scale)
    router_w = nrm((DEPTH, d, N_EXPERTS), d ** -0.5)
    router_b = nrm((DEPTH, N_EXPERTS), 0.01)
    moe_w_gu = nrm((DEPTH, N_EXPERTS, d, 2 * D_EXPERT), d ** -0.5)
    moe_b_gu = nrm((DEPTH, N_EXPERTS, 2 * D_EXPERT), 0.02)
    moe_w_dn = nrm((DEPTH, N_EXPERTS, D_EXPERT, d), D_EXPERT ** -0.5 * (2 * DEPTH) ** -0.5)
    moe_b_dn = nrm((DEPTH, N_EXPERTS, d), 0.02)
    ple_w = nrm((DEPTH, PLE_DIM, d), PLE_DIM ** -0.5)
    ple_norm = gain((DEPTH, d))
    ple_gate_norm = gain((DEPTH, d))
    ple_gate_w = nrm((DEPTH, d, d), d ** -0.5)
    return {'x': x, 'p': p, 'norm_mix': norm_mix, 'norm_ffn': norm_ffn,
            'hg_w_in': hg_w_in, 'hg_w_out': hg_w_out, 'hg_gnorm': hg_gnorm, 'hg_lb_param': hg_lb_param,
            'fox_w_in': fox_w_in, 'fox_f_bias': fox_f_bias, 'fox_qnorm': fox_qnorm, 'fox_knorm': fox_knorm,
            'fox_w_out': fox_w_out,
            'rg_w_in': rg_w_in, 'rg_conv_w': rg_conv_w, 'rg_conv_b': rg_conv_b, 'rg_wa': rg_wa, 'rg_ba': rg_ba,
            'rg_wx': rg_wx, 'rg_bx': rg_bx, 'rg_lambda': rg_lambda, 'rg_w_out': rg_w_out,
            'router_w': router_w, 'router_b': router_b, 'moe_w_gu': moe_w_gu, 'moe_b_gu': moe_b_gu,
            'moe_w_dn': moe_w_dn, 'moe_b_dn': moe_b_dn,
            'ple_w': ple_w, 'ple_norm': ple_norm, 'ple_gate_norm': ple_gate_norm, 'ple_gate_w': ple_gate_w}


def reference(x, p, norm_mix, norm_ffn, hg_w_in, hg_w_out, hg_gnorm, hg_lb_param,
              fox_w_in, fox_f_bias, fox_qnorm, fox_knorm, fox_w_out,
              rg_w_in, rg_conv_w, rg_conv_b, rg_wa, rg_ba, rg_wx, rg_bx, rg_lambda, rg_w_out,
              router_w, router_b, moe_w_gu, moe_b_gu, moe_w_dn, moe_b_dn,
              ple_w, ple_norm, ple_gate_norm, ple_gate_w):
    lb_all = jnp.cumsum(jax.nn.softmax(hg_lb_param.astype(jnp.float32), axis=0), axis=0)
    lb_all = lb_all - lb_all[0]
    h = x
    for i in range(DEPTH):
        xn = rmsnorm(h, norm_mix[i])
        j = i // N_MIXERS
        kind = i % N_MIXERS
        if kind == 0:
            mix = hgrn2_mixer(xn, hg_w_in[j], hg_w_out[j], hg_gnorm[j], lb_all[i])
        elif kind == 1:
            mix = fox_mixer(xn, fox_w_in[j], fox_f_bias[j], fox_qnorm[j], fox_knorm[j], fox_w_out[j])
        else:
            mix = rglru_mixer(xn, rg_w_in[j], rg_conv_w[j], rg_conv_b[j], rg_wa[j], rg_ba[j],
                              rg_wx[j], rg_bx[j], rg_lambda[j], rg_w_out[j])
        h = h + mix
        h = h + moe(rmsnorm(h, norm_ffn[i]), router_w[i], router_b[i],
                    moe_w_gu[i], moe_b_gu[i], moe_w_dn[i], moe_b_dn[i])
        ple = (rmsnorm(p[i] @ ple_w[i], ple_norm[i])
               * jax.nn.sigmoid(rmsnorm(h, ple_gate_norm[i]) @ ple_gate_w[i]))
        h = h + ple
    return h
```

```cpp
#define MK_PER_PHASE 1
#include <hip/hip_runtime.h>
#include <cstdio>
#include <cstdint>
#include <hip/hip_bf16.h>
#include <cmath>

#ifndef MK_PER_PHASE
#define MK_PER_PHASE 0
#endif

#define GAS __attribute__((address_space(1)))
#define LAS __attribute__((address_space(3)))
typedef unsigned short bf16;
typedef unsigned short bf16_t;
typedef short bf16x8 __attribute__((ext_vector_type(8)));
typedef float f32x4 __attribute__((ext_vector_type(4)));
typedef float f32x2 __attribute__((ext_vector_type(2)));
typedef float f32x16 __attribute__((ext_vector_type(16)));
typedef unsigned u32x4 __attribute__((ext_vector_type(4)));
typedef unsigned u32x2 __attribute__((ext_vector_type(2)));
typedef GAS unsigned gu32;
#define RLX_AGENT __ATOMIC_RELAXED, __HIP_MEMORY_SCOPE_AGENT
#define LDS_WAIT() asm volatile("s_waitcnt lgkmcnt(0)" ::: "memory")
#define VM_WAIT() asm volatile("s_waitcnt vmcnt(0)" ::: "memory")

constexpr int NB = 4, SEQ = 8192, DM = 1024, M = NB * SEQ, DEPTH = 4;
constexpr int NEXP = 32, TOPK = 4, PLED = 256;
constexpr int FOXH = 16;
constexpr float EPS = 1e-6f;
constexpr int NWAVES = 8, NTHR = 512;

enum { I_X = 0, I_P, I_NORM_MIX, I_NORM_FFN, I_HG_WIN, I_HG_WOUT, I_HG_GNORM, I_HG_LB, I_FOX_WIN, I_FOX_FB, I_FOX_QN, I_FOX_KN, I_FOX_WOUT,
       I_RG_WIN, I_RG_CW, I_RG_CB, I_RG_WA, I_RG_BA, I_RG_WX, I_RG_BX, I_RG_LAM, I_RG_WOUT, I_RT_W, I_RT_B, I_GU_W, I_GU_B, I_DN_W, I_DN_B,
       I_PLE_W, I_PLE_N, I_PLE_GN, I_PLE_GW, N_IN };

struct Args { const float* in[N_IN]; float* out; unsigned char* ws; int lo, hi; };
typedef const __attribute__((address_space(4))) Args CArgs;
__device__ __forceinline__ CArgs* args_ptr() { CArgs* p = (CArgs*)__builtin_amdgcn_kernarg_segment_ptr(); asm volatile("" : "+s"(p)); return p; }

constexpr size_t MiB = 1u << 20;
constexpr size_t WS_CTL = 0, CTL_ZERO_BYTES = 1 * MiB;
constexpr size_t WS_SMALL = 1 * MiB;
constexpr size_t WS_W_HGIN = 8 * MiB;
constexpr size_t WS_W_HGOUT = 24 * MiB;
constexpr size_t WS_W_FOXIN = 28 * MiB;
constexpr size_t WS_W_FOXOUT = 36 * MiB;
constexpr size_t WS_W_RGIN = 38 * MiB;
constexpr size_t WS_W_RGAX = 42 * MiB;
constexpr size_t WS_W_RGOUT = 43 * MiB;
constexpr size_t WS_W_PLE = 45 * MiB;
constexpr size_t WS_W_PLEG = 47 * MiB;
constexpr size_t WS_W_GU = 64 * MiB;
constexpr size_t WS_W_DN = 576 * MiB;
constexpr size_t WS_PB = 832 * MiB;
constexpr size_t WS_H = 896 * MiB;
constexpr size_t WS_XN = 1024 * MiB;
constexpr size_t WS_PROJ = 1088 * MiB;
constexpr size_t WS_F32A = 1344 * MiB;
constexpr size_t WS_F32B = 1472 * MiB;
constexpr size_t WS_HGG = 1600 * MiB;
constexpr size_t WS_HGS = 1856 * MiB;
constexpr size_t WS_MIXO = 1984 * MiB;
constexpr size_t WS_ACT = 2048 * MiB;
constexpr size_t WS_Y = 2320 * MiB;
constexpr size_t WS_LENT = 2576 * MiB;
constexpr size_t WS_LGATE = 2580 * MiB;
constexpr size_t WS_PW = 2584 * MiB;
constexpr size_t WS_PSS = 2648 * MiB;
constexpr size_t WS_PRSTD = 2650 * MiB;
constexpr size_t WS_GN = 2652 * MiB;
constexpr size_t WS_LSIG = 2716 * MiB;
constexpr size_t WS_FCUM = 2718 * MiB;
constexpr size_t WS_KC = 2720 * MiB;
constexpr size_t WS_HGDEC = 2728 * MiB;
constexpr size_t WS_SCAN = 2730 * MiB;
constexpr size_t WS_END = 2736 * MiB;
constexpr size_t SM_LB0 = 0, SM_LB3 = 4096, SM_SP8 = 8192;

constexpr int CW_TMO = 0, CW_CODE = 1;
constexpr int CW_CNT = 1024;
constexpr int CW_BAR = 4096;

constexpr int RING_BYTES = 131072;
constexpr int LDSX_OFF = RING_BYTES;
constexpr int LDSX_BYTES = 24576;
constexpr int MISC_OFF = LDSX_OFF + LDSX_BYTES;
constexpr int LDS_BYTES = MISC_OFF + 128;

__device__ __forceinline__ int opaque_v(int x) { asm volatile("" : "+v"(x)); return x; }
__device__ __forceinline__ int hw_lane() { int l; asm volatile("v_mbcnt_lo_u32_b32 %0, -1, 0\n\tv_mbcnt_hi_u32_b32 %0, -1, %0" : "=v"(l)); return l; }
__device__ __forceinline__ unsigned f2bf(float f) { unsigned u = __builtin_bit_cast(unsigned, f); return (u + 0x7fffu + ((u >> 16) & 1u)) >> 16; }
__device__ __forceinline__ unsigned pk2(float lo, float hi) { return f2bf(lo) | (f2bf(hi) << 16); }
__device__ __forceinline__ float bf2f(unsigned short b) { return __builtin_bit_cast(float, (unsigned)b << 16); }
__device__ __forceinline__ float bflo(unsigned w) { return __builtin_bit_cast(float, w << 16); }
__device__ __forceinline__ float bfhi(unsigned w) { return __builtin_bit_cast(float, w & 0xffff0000u); }
__device__ __forceinline__ unsigned cvt_pk_bf16(float lo, float hi) { unsigned r; asm volatile("v_cvt_pk_bf16_f32 %0, %1, %2" : "=v"(r) : "v"(lo), "v"(hi)); return r; }
__device__ __forceinline__ float fexp(float x) { return __builtin_amdgcn_exp2f(x * 1.4426950408889634f); }
__device__ __forceinline__ float frcp(float x) { return __builtin_amdgcn_rcpf(x); }
__device__ __forceinline__ float sigmoidf_(float x) { return frcp(1.f + fexp(-x)); }
template <int MASK> __device__ __forceinline__ float sx(float v) { static_assert(MASK > 0 && MASK < 32, "sx: xor mask inside a 32-lane half"); return __builtin_bit_cast(float, __builtin_amdgcn_ds_swizzle(__builtin_bit_cast(int, v), (MASK << 10) | 0x1F)); }
__device__ __forceinline__ void swap32(float& a, float& b) { asm volatile("s_nop 1\n\tv_permlane32_swap_b32 %0, %1\n\ts_nop 1" : "+v"(a), "+v"(b)); }
__device__ __forceinline__ float add_x32(float v) { float a = v, b = v; swap32(a, b); return a + b; }
__device__ __forceinline__ float max_x32(float v) { float a = v, b = v; swap32(a, b); return fmaxf(a, b); }
__device__ __forceinline__ float wave_sum(float v) { v += sx<1>(v); v += sx<2>(v); v += sx<4>(v); v += sx<8>(v); v += sx<16>(v); return add_x32(v); }
__device__ __forceinline__ float wave_max(float v) { v = fmaxf(v, sx<1>(v)); v = fmaxf(v, sx<2>(v)); v = fmaxf(v, sx<4>(v)); v = fmaxf(v, sx<8>(v)); v = fmaxf(v, sx<16>(v)); return max_x32(v); }
#define XB_TMO      128
#define XB_XCNT(j)  (256  + 64 * (j))
#define XB_XSUB(j)  (1280 + 64 * (j))
#define XB_XGEN(j)  (2304 + 64 * (j))
#define XB_TOP      3328
#define XB_TOPGEN   3392
#define XCD_BAR_WORDS 3456
#define XB_SPIN_CAP (1u << 18)

__device__ __forceinline__ unsigned xb_ld(unsigned* p)              { return __hip_atomic_load(p, __ATOMIC_RELAXED, __HIP_MEMORY_SCOPE_AGENT); }
__device__ __forceinline__ unsigned xb_add(unsigned* p, unsigned v) { return __hip_atomic_fetch_add(p, v, __ATOMIC_RELAXED, __HIP_MEMORY_SCOPE_AGENT); }
__device__ __forceinline__ unsigned xb_xcc_id() { return (unsigned)__builtin_amdgcn_s_getreg((3 << 11) | 20) & 0xFu; }
#define XB_SPIN(cond, bar) do { unsigned _sp = 0; while (cond) { __builtin_amdgcn_s_sleep(1); \
    if ((++_sp & 255u) == 0u) { if (xb_ld(&(bar)[XB_TMO])) break; if (_sp > XB_SPIN_CAP) { atomicAdd(&(bar)[XB_TMO], 1u); break; } } } } while (0)

struct XcdBarrier {
    unsigned* bar; unsigned x;
    volatile LAS unsigned* st;
};

__device__ __forceinline__ XcdBarrier xcd_barrier_post(unsigned* bar, volatile LAS unsigned* st) {
    XcdBarrier b; b.bar = bar; b.x = xb_xcc_id(); b.st = st;
    if (threadIdx.x == 0) (void)xb_add(&bar[XB_XCNT(b.x)], 1u);
    return b;
}
__device__ __forceinline__ void xcd_barrier_complete(unsigned* bar, unsigned x, unsigned& nloc, unsigned& nx) {
    const unsigned G = gridDim.x * gridDim.y * gridDim.z;
    unsigned sum, cnt, mine, sp = 0u;
    for (;;) {
        sum = 0u; cnt = 0u; mine = 0u;
#pragma unroll
        for (unsigned j = 0; j < 16; ++j) { const unsigned c = xb_ld(&bar[XB_XCNT(j)]); sum += c; cnt += (c > 0u) ? 1u : 0u; mine = (j == x) ? c : mine; }
        if (sum == G) break;
        __builtin_amdgcn_s_sleep(1);
        if ((++sp & 255u) == 0u) { if (xb_ld(&bar[XB_TMO])) break; if (sp > XB_SPIN_CAP) { atomicAdd(&bar[XB_TMO], 1u); break; } }
    }
    nloc = mine > 0u ? mine : 1u; nx = cnt > 0u ? cnt : 1u;
}

__device__ __forceinline__ void xcd_barrier(const XcdBarrier& b) {
    asm volatile("s_waitcnt vmcnt(0)" ::: "memory");
    __syncthreads();
    if (threadIdx.x == 0) {
        unsigned* bar = b.bar;
        __builtin_amdgcn_s_waitcnt(0);
        unsigned nloc = b.st[0], nx = b.st[1];
        if (nloc == 0u) { xcd_barrier_complete(bar, b.x, nloc, nx); b.st[0] = nloc; b.st[1] = nx; }
        const unsigned old = xb_add(&bar[XB_XSUB(b.x)], 1u);
        const unsigned gen = old / nloc;
        if (old + 1u == (gen + 1u) * nloc) {
            __builtin_amdgcn_fence(__ATOMIC_RELEASE, "agent");
            asm volatile("s_waitcnt vmcnt(0)" ::: "memory");
            const unsigned og = xb_add(&bar[XB_TOP], 1u);
            const unsigned tg = og / nx;
            if (og + 1u == (tg + 1u) * nx) xb_add(&bar[XB_TOPGEN], 1u);
            else XB_SPIN(xb_ld(&bar[XB_TOPGEN]) == tg, bar);
            __builtin_amdgcn_fence(__ATOMIC_ACQUIRE, "agent");
            xb_add(&bar[XB_XGEN(b.x)], 1u);
            asm volatile("s_waitcnt vmcnt(0)" ::: "memory");
        } else {
            XB_SPIN(xb_ld(&bar[XB_XGEN(b.x)]) == gen, bar);
            __builtin_amdgcn_fence(__ATOMIC_ACQUIRE, "agent");
            asm volatile("s_waitcnt vmcnt(0)" ::: "memory");
        }
    }
    __syncthreads();
}

namespace pg8 {
constexpr int BM = 256, BK = 64, HALF = 128, HTB = HALF * BK * 2  , NXCD = 8, WGM = 8;
__host__ __device__ __forceinline__ int lds_byte(int r, int c) { const int st = (r >> 4) * 2 + (c >> 5), rr = r & 15, cc = c & 31, ob = rr * 64 + cc * 2; return st * 1024 + (ob ^ (((ob >> 9) & 1) << 5)); }
__host__ __device__ __forceinline__ void stage_rc(int b, int& R, int& C) { const int st = b / 1024, sb = b % 1024, swz = sb ^ (((sb >> 9) & 1) << 5); R = (st >> 1) * 16 + swz / 64; C = (st & 1) * 32 + (swz % 64) / 2; }
__host__ __device__ __forceinline__ int perm32(int rho) { const int n = rho >> 4, i = rho & 15; return 8 * (i >> 2) + 4 * n + (i & 3); }

__device__ __forceinline__ void glds16s(const void* sbase, unsigned voff, unsigned lds_dst) { unsigned keep;
    asm volatile("s_mov_b32 %0, m0\n\ts_mov_b32 m0, %3\n\ts_nop 0\n\tglobal_load_lds_dwordx4 %1, %2\n\ts_mov_b32 m0, %0" : "=&s"(keep) : "v"(voff), "s"(sbase), "s"(lds_dst) : "memory"); }
struct Unit { int pm, pn, e, nv; };
struct GemmD { int K, lda; };

struct StaticOrder {
    int nM, nN, nwg, G, c; const char* A; const char* B; int K, lda; int a_pn_shift;
    static constexpr bool GATHER = false;
    __device__ void init(const void* A_, const void* B_, int Mrows, int N, int K_, int lda_, int G_, int c_, int aps = -1) { A = (const char*)A_; B = (const char*)B_; nM = Mrows / BM; nN = N / BM; nwg = nM * nN; G = G_; c = c_; K = K_; lda = lda_; a_pn_shift = aps; }
    __device__ __forceinline__ bool next(int i, Unit& u) const {
        const long L = (long)i * G + c; if (L >= nwg) return false;
        int wgid = (int)L; { const int q = nwg / NXCD, r = nwg % NXCD, xcd = wgid % NXCD, off = wgid / NXCD; wgid = (xcd < r ? xcd * (q + 1) : r * (q + 1) + (xcd - r) * q) + off; }
        const int nig = WGM * nN, gid = wgid / nig, fm = gid * WGM, gsz = (nM - fm) < WGM ? (nM - fm) : WGM;
        u.pm = fm + ((wgid % nig) % gsz); u.pn = (wgid % nig) / gsz; u.e = 0; u.nv = 256; return true;
    }
    __device__ __forceinline__ const char* a_ptr(const Unit& u) const { return A + ((size_t)u.pm * BM * lda + (a_pn_shift >= 0 ? (size_t)(u.pn >> a_pn_shift) * K : 0)) * 2; }
    __device__ __forceinline__ const char* b_ptr(const Unit& u) const { return B + (size_t)u.pn * BM * K * 2; }
    __device__ __forceinline__ void gather(const Unit&, int, int, int (&rows)[4]) const { rows[0] = rows[1] = rows[2] = rows[3] = 0; }
};

template <class Epi, class Sched, bool ALIGN_EPI>
__device__ __forceinline__ void gemm_phase(LAS unsigned char* lds, int wid, const GemmD g, const Sched& S, const Epi& E) {
    const int lane = hw_lane(), tid = wid * 64 + lane, wr = wid >> 2, wc = wid & 3, fr = lane & 15, fq = lane >> 4;
    const int K = g.K, nt = K / BK, lda = g.lda;
    int R[2], C[2]; unsigned voffB[2];
#pragma unroll
    for (int i = 0; i < 2; ++i) { stage_rc(tid * 16 + i * 8192, R[i], C[i]); const int Rb = (R[i] & ~31) + perm32(R[i] & 31); voffB[i] = (unsigned)(Rb * K + C[i]) * 2u; }
    const size_t kstep = (size_t)(BK * 2);
    const size_t hstepB = (size_t)HALF * K * 2;
    const size_t hstepA = Sched::GATHER ? 0 : (size_t)HALF * lda * 2;
    const unsigned lds0 = (unsigned)(uintptr_t)lds + (unsigned)wid * 1024u;
    const int aoff = lds_byte(wr * 64 + fr, fq * 8), boff = lds_byte(wc * 32 + fr, fq * 8);
#define PG8_SA(b, h) (((b) * 2 + (h)) * HTB)
#define PG8_SB(b, h) ((4 + (b) * 2 + (h)) * HTB)
#define PG8_STAGEB(bufoff, gbase) do { glds16s((gbase), voffB[0], lds0 + (bufoff)); glds16s((gbase), voffB[1], lds0 + (bufoff) + 8192); } while (0)
#define PG8_STAGEA(bufoff, gbase, v0, v1) do { glds16s((gbase), (v0), lds0 + (bufoff)); glds16s((gbase), (v1), lds0 + (bufoff) + 8192); } while (0)
#define PG8_LDA(dst, b, h) do { _Pragma("unroll") for (int m = 0; m < 4; ++m) _Pragma("unroll") for (int k = 0; k < 2; ++k) dst[m][k] = *(const LAS bf16x8*)(lds + PG8_SA(b, h) + aoff + m * 2048 + k * 1024); } while (0)
#define PG8_LDB(dst, b, h) do { _Pragma("unroll") for (int n = 0; n < 2; ++n) _Pragma("unroll") for (int k = 0; k < 2; ++k) dst[n][k] = *(const LAS bf16x8*)(lds + PG8_SB(b, h) + boff + n * 2048 + k * 1024); } while (0)
#define PG8_MMA(ai, bj, At, Bt) do { __builtin_amdgcn_s_setprio(1); _Pragma("unroll") for (int m = 0; m < 4; ++m) _Pragma("unroll") for (int n = 0; n < 2; ++n) _Pragma("unroll") for (int k = 0; k < 2; ++k) \
        acc[ai][bj][m][n] = __builtin_amdgcn_mfma_f32_16x16x32_bf16(Bt[n][k], At[m][k], acc[ai][bj][m][n], 0, 0, 0); __builtin_amdgcn_s_setprio(0); } while (0)
#define PG8_WAIT_V(n) asm volatile("s_waitcnt vmcnt(" #n ")" ::: "memory")
#define PG8_WAIT_L(n) asm volatile("s_waitcnt lgkmcnt(" #n ")" ::: "memory")
#define PG8_BAR __builtin_amdgcn_s_barrier()
#define PG8_SCHED __builtin_amdgcn_sched_barrier(0)
#define PG8_OFFS(dst, rows) do { if constexpr (Sched::GATHER) { dst[0] = (unsigned)(rows[0] * lda + C[0]) * 2u; dst[1] = (unsigned)(rows[1] * lda + C[1]) * 2u; dst[2] = (unsigned)(rows[2] * lda + C[0]) * 2u; dst[3] = (unsigned)(rows[3] * lda + C[1]) * 2u; } } while (0)
    Unit cur, nxt, nn; int ui = 0;
    if (!S.next(0, cur)) return;
    bool has_next = S.next(1, nxt);
    unsigned vAc[4], vAn[4];
    if constexpr (Sched::GATHER) {
        int r0[4], r1[4]; S.gather(cur, R[0], R[1], r0); if (has_next) S.gather(nxt, R[0], R[1], r1); else { r1[0] = r0[0]; r1[1] = r0[1]; r1[2] = r0[2]; r1[3] = r0[3]; }
        PG8_OFFS(vAc, r0); PG8_OFFS(vAn, r1);
    } else {
#pragma unroll
        for (int h = 0; h < 2; ++h)
#pragma unroll
            for (int i = 0; i < 2; ++i) { vAc[h * 2 + i] = (unsigned)(R[i] * lda + C[i]) * 2u; vAn[h * 2 + i] = vAc[h * 2 + i]; }
    }
    f32x4 acc[2][2][4][2];
#pragma unroll
    for (int a = 0; a < 2; ++a)
#pragma unroll
        for (int b = 0; b < 2; ++b)
#pragma unroll
            for (int m = 0; m < 4; ++m)
#pragma unroll
                for (int n = 0; n < 2; ++n) acc[a][b][m][n] = (f32x4){0.f, 0.f, 0.f, 0.f};
    bf16x8 At[4][2], B0[2][2], B1[2][2];
    const char* cA = S.a_ptr(cur); const char* cB = S.b_ptr(cur);
    PG8_STAGEB(PG8_SB(0, 0), cB); PG8_STAGEB(PG8_SB(0, 1), cB + hstepB); PG8_STAGEA(PG8_SA(0, 0), cA, vAc[0], vAc[1]); PG8_STAGEA(PG8_SA(0, 1), cA + hstepA, vAc[2], vAc[3]);
    if (wr == 1) PG8_BAR;
    PG8_WAIT_V(2); PG8_BAR;
    PG8_STAGEB(PG8_SB(1, 0), cB + kstep); PG8_STAGEA(PG8_SA(1, 0), cA + kstep, vAc[0], vAc[1]); PG8_STAGEB(PG8_SB(1, 1), cB + hstepB + kstep);
    PG8_WAIT_V(6); PG8_BAR;
    for (;;) {
        const char* nA = has_next ? S.a_ptr(nxt) : cA; const char* nB = has_next ? S.b_ptr(nxt) : cB;
        for (int t = 0; t < nt; t += 2) {
            const bool last = (t == nt - 2);
            const char* a1 = cA + (size_t)(t + 1) * kstep;
            const char* a2 = last ? nA : cA + (size_t)(t + 2) * kstep; const char* b2 = last ? nB : cB + (size_t)(t + 2) * kstep;
            const char* a3 = a2 + kstep; const char* b3 = b2 + kstep;
            unsigned x0 = vAc[0], x1 = vAc[1], x2 = vAc[2], x3 = vAc[3];
            if constexpr (Sched::GATHER) { if (last) { x0 = vAn[0]; x1 = vAn[1]; x2 = vAn[2]; x3 = vAn[3]; } }
            PG8_LDB(B0, 0, 0); PG8_LDB(B1, 0, 1); PG8_SCHED; PG8_LDA(At, 0, 0); PG8_STAGEA(PG8_SA(1, 1), a1 + hstepA, vAc[2], vAc[3]);
            PG8_WAIT_V(8); PG8_WAIT_L(0); PG8_BAR; PG8_MMA(0, 0, At, B0); PG8_MMA(0, 1, At, B1); PG8_BAR; PG8_SCHED;
            PG8_LDA(At, 0, 1); PG8_STAGEB(PG8_SB(0, 0), b2); PG8_STAGEB(PG8_SB(0, 1), b2 + hstepB); PG8_STAGEA(PG8_SA(0, 0), a2, x0, x1);
            PG8_WAIT_V(8); PG8_WAIT_L(0); PG8_BAR; PG8_MMA(1, 0, At, B0); PG8_MMA(1, 1, At, B1); PG8_BAR; PG8_SCHED;
            PG8_LDB(B0, 1, 0); PG8_LDB(B1, 1, 1); PG8_SCHED; PG8_LDA(At, 1, 0); PG8_STAGEA(PG8_SA(0, 1), a2 + hstepA, x2, x3);
            PG8_WAIT_V(8); PG8_WAIT_L(0); PG8_BAR; PG8_MMA(0, 0, At, B0); PG8_MMA(0, 1, At, B1); PG8_BAR; PG8_SCHED;
            PG8_LDA(At, 1, 1); PG8_STAGEB(PG8_SB(1, 0), b3); PG8_STAGEB(PG8_SB(1, 1), b3 + hstepB); PG8_STAGEA(PG8_SA(1, 0), a3, x0, x1);
            PG8_WAIT_V(8); PG8_WAIT_L(0); PG8_BAR; PG8_MMA(1, 0, At, B0); PG8_MMA(1, 1, At, B1); PG8_BAR; PG8_SCHED;
        }
        bool has_nn = false; int rn[4] = {0, 0, 0, 0};
        if (has_next) { has_nn = S.next(ui + 2, nn); if constexpr (Sched::GATHER) { if (has_nn) S.gather(nn, R[0], R[1], rn); } }
        if constexpr (ALIGN_EPI) { if (wr == 0) PG8_BAR; }
        E(acc, cur, wr, wc, fr, fq);
        if (!has_next) break;
#pragma unroll
        for (int a = 0; a < 2; ++a)
#pragma unroll
            for (int b = 0; b < 2; ++b)
#pragma unroll
                for (int m = 0; m < 4; ++m)
#pragma unroll
                    for (int n = 0; n < 2; ++n) acc[a][b][m][n] = (f32x4){0.f, 0.f, 0.f, 0.f};
        cur = nxt; cA = nA; cB = nB; ++ui;
        if constexpr (Sched::GATHER) { vAc[0] = vAn[0]; vAc[1] = vAn[1]; vAc[2] = vAn[2]; vAc[3] = vAn[3]; if (has_nn) PG8_OFFS(vAn, rn); }
        nxt = nn; has_next = has_nn;
        if constexpr (ALIGN_EPI) { if (wr == 1) PG8_BAR; }
    }
    PG8_WAIT_V(0);
    if constexpr (!ALIGN_EPI) { if (wr == 0) PG8_BAR; }
    PG8_BAR;
#undef PG8_SA
#undef PG8_SB
#undef PG8_STAGEA
#undef PG8_STAGEB
#undef PG8_LDA
#undef PG8_LDB
#undef PG8_MMA
#undef PG8_WAIT_V
#undef PG8_WAIT_L
#undef PG8_BAR
#undef PG8_SCHED
#undef PG8_OFFS
}
}

namespace pg8 {
template <bool GATHER_, int CSH>
struct MoeOrder {
    static constexpr bool GATHER = GATHER_;
    const LAS int* tab; int G, vcu, total; const char* A; const char* B; size_t b_estride; int K, lda; const unsigned* lent;
    __device__ __forceinline__ bool next(int i, Unit& u) const {
        const int L = i * G + vcu; if (L >= total) return false;
        const int tile = L >> CSH; int e = 0;
        while (tab[e + 1] <= tile) ++e;
        e = __builtin_amdgcn_readfirstlane(e);
        const int rt = tile - __builtin_amdgcn_readfirstlane(tab[e]); const int rem = __builtin_amdgcn_readfirstlane(tab[40 + e]) - rt * 256;
        u.pm = tile; u.pn = L & ((1 << CSH) - 1); u.e = e; u.nv = rem < 256 ? rem : 256; return true;
    }
    __device__ __forceinline__ int lbase(const Unit& u) const { return u.e * 32768 + (u.pm - __builtin_amdgcn_readfirstlane(tab[u.e])) * 256; }
    __device__ __forceinline__ const char* a_ptr(const Unit& u) const { return GATHER ? A : A + (size_t)u.pm * 256 * lda * 2; }
    __device__ __forceinline__ const char* b_ptr(const Unit& u) const { return B + (size_t)u.e * b_estride + (size_t)u.pn * 256 * K * 2; }
    __device__ __forceinline__ void gather(const Unit& u, int R0, int R1, int (&rows)[4]) const {
        const unsigned* l = lent + lbase(u);
        const int i0 = R0, i1 = R1, i2 = 128 + R0, i3 = 128 + R1;
        rows[0] = i0 < u.nv ? (int)(l[i0] >> 2) : 0; rows[1] = i1 < u.nv ? (int)(l[i1] >> 2) : 0;
        rows[2] = i2 < u.nv ? (int)(l[i2] >> 2) : 0; rows[3] = i3 < u.nv ? (int)(l[i3] >> 2) : 0;
    }
};

#define EPI_ARGS const f32x4 (&acc)[2][2][4][2], const Unit& u, int wr, int wc, int fr, int fq
__device__ __forceinline__ void st_bf8(bf16* p, f32x4 v0, f32x4 v1) { u32x4 w; w.x = cvt_pk_bf16(v0[0], v0[1]); w.y = cvt_pk_bf16(v0[2], v0[3]); w.z = cvt_pk_bf16(v1[0], v1[1]); w.w = cvt_pk_bf16(v1[2], v1[3]); *(u32x4*)p = w; }
__device__ __forceinline__ float silu_(float x) { return x * frcp(1.f + fexp(-x)); }

struct EpiHgIn {
    bf16 *Q, *Kk, *V, *G; float* LF; const float* lb;
    __device__ __forceinline__ void operator()(EPI_ARGS) const {
        const int sec = u.pn >> 2, row0 = u.pm * 256 + wr * 64 + fr, col0 = (u.pn & 3) * 256 + wc * 32 + 8 * fq;
        f32x4 lbv[2][2];
#pragma unroll
        for (int bj = 0; bj < 2; ++bj) { lbv[bj][0] = *(const f32x4*)(lb + col0 + bj * 128); lbv[bj][1] = *(const f32x4*)(lb + col0 + bj * 128 + 4); }
#pragma unroll
        for (int ai = 0; ai < 2; ++ai)
#pragma unroll
            for (int m = 0; m < 4; ++m) { const size_t ro = (size_t)(row0 + ai * 128 + m * 16) * DM;
#pragma unroll
                for (int bj = 0; bj < 2; ++bj) { const int col = col0 + bj * 128; f32x4 v0 = acc[ai][bj][m][0], v1 = acc[ai][bj][m][1];
                    if (sec == 0) {
#pragma unroll
                        for (int j = 0; j < 4; ++j) { v0[j] = silu_(v0[j]) * 0.08838834764831845f; v1[j] = silu_(v1[j]) * 0.08838834764831845f; }
                        st_bf8(Q + ro + col, v0, v1);
                    } else if (sec == 1) {
                        f32x4 l0, l1, k0, k1;
#pragma unroll
                        for (int j = 0; j < 4; ++j) {
                            { const float z = fmaxf(v0[j], -80.f), e = fexp(-z), s = frcp(1.f + e), lbb = lbv[bj][0][j]; l0[j] = __logf(lbb + (1.f - lbb) * s); k0[j] = (1.f - lbb) * e * s; }
                            { const float z = fmaxf(v1[j], -80.f), e = fexp(-z), s = frcp(1.f + e), lbb = lbv[bj][1][j]; l1[j] = __logf(lbb + (1.f - lbb) * s); k1[j] = (1.f - lbb) * e * s; }
                        }
                        *(f32x4*)(LF + ro + col) = l0; *(f32x4*)(LF + ro + col + 4) = l1;
                        st_bf8(Kk + ro + col, k0, k1);
                    } else if (sec == 2) { st_bf8(V + ro + col, v0, v1);
                    } else {
#pragma unroll
                        for (int j = 0; j < 4; ++j) { v0[j] = silu_(v0[j]); v1[j] = silu_(v1[j]); }
                        st_bf8(G + ro + col, v0, v1);
                    } } __builtin_amdgcn_sched_barrier(0); }
    }
};

struct EpiResid {
    const float* src; float* dst;
    __device__ __forceinline__ void operator()(EPI_ARGS) const {
        const int row0 = u.pm * 256 + wr * 64 + fr, col0 = u.pn * 256 + wc * 32 + 8 * fq;
#pragma unroll
        for (int ai = 0; ai < 2; ++ai)
#pragma unroll
            for (int m = 0; m < 4; ++m) { const size_t ro = (size_t)(row0 + ai * 128 + m * 16) * DM;
#pragma unroll
                for (int bj = 0; bj < 2; ++bj) { const size_t o = ro + col0 + bj * 128;
                    const f32x4 a = *(const f32x4*)(src + o), b = *(const f32x4*)(src + o + 4);
                    *(f32x4*)(dst + o) = a + acc[ai][bj][m][0]; *(f32x4*)(dst + o + 4) = b + acc[ai][bj][m][1]; } }
    }
};

struct EpiFoxIn {
    bf16 *Q, *Kk, *V, *G; const float *qn, *kn; float qscale;
    __device__ __forceinline__ void operator()(EPI_ARGS) const {
        const int sec = u.pn >> 2, pnl = u.pn & 3, row0 = u.pm * 256 + wr * 64 + fr;
        if (sec < 2) {
            const float* gn = sec == 0 ? qn : kn; const float sc = sec == 0 ? qscale : 1.f; bf16* O = sec == 0 ? Q : Kk;
            f32x4 g[2][2];
#pragma unroll
            for (int bj = 0; bj < 2; ++bj) { g[bj][0] = *(const f32x4*)(gn + bj * 32 + 8 * fq) * sc; g[bj][1] = *(const f32x4*)(gn + bj * 32 + 8 * fq + 4) * sc; }
            const int colh = (pnl * 4 + wc) * 64 + 8 * fq;
#pragma unroll
            for (int ai = 0; ai < 2; ++ai)
#pragma unroll
                for (int m = 0; m < 4; ++m) { const size_t ro = (size_t)(row0 + ai * 128 + m * 16) * DM;
                    float ss = 0.f;
#pragma unroll
                    for (int bj = 0; bj < 2; ++bj)
#pragma unroll
                        for (int n = 0; n < 2; ++n) { const f32x4 x = acc[ai][bj][m][n]; ss += (x[0] * x[0] + x[1] * x[1]) + (x[2] * x[2] + x[3] * x[3]); }
                    ss += sx<16>(ss); ss = add_x32(ss);
                    const float rstd = __builtin_amdgcn_rsqf(ss * (1.f / 64.f) + EPS);
#pragma unroll
                    for (int bj = 0; bj < 2; ++bj) st_bf8(O + ro + colh + bj * 32, acc[ai][bj][m][0] * rstd * g[bj][0], acc[ai][bj][m][1] * rstd * g[bj][1]); __builtin_amdgcn_sched_barrier(0); }
        } else {
            const int col0 = pnl * 256 + wc * 32 + 8 * fq;
#pragma unroll
            for (int ai = 0; ai < 2; ++ai)
#pragma unroll
                for (int m = 0; m < 4; ++m) { const size_t ro = (size_t)(row0 + ai * 128 + m * 16) * DM;
#pragma unroll
                    for (int bj = 0; bj < 2; ++bj) { f32x4 v0 = acc[ai][bj][m][0], v1 = acc[ai][bj][m][1];
                        if (sec == 3) {
#pragma unroll
                            for (int j = 0; j < 4; ++j) { v0[j] = sigmoidf_(v0[j]); v1[j] = sigmoidf_(v1[j]); } }
                        st_bf8((sec == 2 ? V : G) + ro + col0 + bj * 128, v0, v1); } __builtin_amdgcn_sched_barrier(0); }
        }
    }
};

__device__ __forceinline__ float gelu_tanh_(float x) { const float t = 1.5957691216057308f * (x + 0.044715f * x * x * x); return x * frcp(1.f + fexp(-t)); }
struct EpiRgIn {
    bf16 *GATE, *U;
    __device__ __forceinline__ void operator()(EPI_ARGS) const {
        const int sec = u.pn >> 2, row0 = u.pm * 256 + wr * 64 + fr, col0 = (u.pn & 3) * 256 + wc * 32 + 8 * fq;
#pragma unroll
        for (int ai = 0; ai < 2; ++ai)
#pragma unroll
            for (int m = 0; m < 4; ++m) { const size_t ro = (size_t)(row0 + ai * 128 + m * 16) * DM;
#pragma unroll
                for (int bj = 0; bj < 2; ++bj) { f32x4 v0 = acc[ai][bj][m][0], v1 = acc[ai][bj][m][1];
                    if (sec == 0) {
#pragma unroll
                        for (int j = 0; j < 4; ++j) { v0[j] = gelu_tanh_(v0[j]); v1[j] = gelu_tanh_(v1[j]); } }
                    st_bf8((sec == 0 ? GATE : U) + ro + col0 + bj * 128, v0, v1); } __builtin_amdgcn_sched_barrier(0); }
    }
};

struct EpiRgGate {
    const bf16* UC; const float *ba, *bx, *sp8; float *A, *X;
    __device__ __forceinline__ void operator()(EPI_ARGS) const {
        const int row0 = u.pm * 256 + wr * 64 + fr, c0 = u.pn * 128 + wc * 32 + 8 * fq;
#pragma unroll
        for (int n = 0; n < 2; ++n) {
            const f32x4 bav = *(const f32x4*)(ba + c0 + 4 * n), bxv = *(const f32x4*)(bx + c0 + 4 * n), spv = *(const f32x4*)(sp8 + c0 + 4 * n);
#pragma unroll
            for (int ai = 0; ai < 2; ++ai) {
                u32x2 uwv[4];
#pragma unroll
                for (int m = 0; m < 4; ++m) uwv[m] = *(const u32x2*)(UC + (size_t)(row0 + ai * 128 + m * 16) * DM + c0 + 4 * n);
                __builtin_amdgcn_sched_barrier(0);
#pragma unroll
                for (int m = 0; m < 4; ++m) { const size_t ro = (size_t)(row0 + ai * 128 + m * 16) * DM + c0 + 4 * n;
                    const float uc[4] = {bflo(uwv[m].x), bfhi(uwv[m].x), bflo(uwv[m].y), bfhi(uwv[m].y)};
                    f32x4 av, xv;
#pragma unroll
                    for (int j = 0; j < 4; ++j) {
                        const float r = sigmoidf_(acc[ai][0][m][n][j] + bav[j]), ig = sigmoidf_(acc[ai][1][m][n][j] + bxv[j]);
                        const float la = -r * spv[j], a = fexp(la), t = 2.f * la;
                        const float em = t * (1.f + t * (0.5f + t * (0.16666667f + t * (0.041666668f + t * 0.008333334f))));
                        av[j] = a; xv[j] = __builtin_sqrtf(fmaxf(-em, 0.f)) * ig * uc[j]; }
                    *(f32x4*)(A + ro) = av; *(f32x4*)(X + ro) = xv; __builtin_amdgcn_sched_barrier(0); } } }
    }
};

struct EpiMoeGU {
    bf16* ACT; const float* bgu;
    __device__ __forceinline__ void operator()(EPI_ARGS) const {
        const int row0 = u.pm * 256 + wr * 64 + fr, c0 = u.pn * 128 + wc * 32 + 8 * fq;
        const float* bb = bgu + (size_t)u.e * 2048 + c0;
        f32x4 bg[2], bl[2];
#pragma unroll
        for (int n = 0; n < 2; ++n) { bg[n] = *(const f32x4*)(bb + 4 * n); bl[n] = *(const f32x4*)(bb + 1024 + 4 * n); }
#pragma unroll
        for (int ai = 0; ai < 2; ++ai)
#pragma unroll
            for (int m = 0; m < 4; ++m) { const size_t ro = (size_t)(row0 + ai * 128 + m * 16) * DM + c0;
                f32x4 o[2];
#pragma unroll
                for (int n = 0; n < 2; ++n)
#pragma unroll
                    for (int j = 0; j < 4; ++j) {
                        const float glu = fminf(acc[ai][0][m][n][j] + bg[n][j], 7.f), lin = fminf(fmaxf(acc[ai][1][m][n][j] + bl[n][j], -7.f), 7.f);
                        o[n][j] = glu * frcp(1.f + fexp(-1.702f * glu)) * (lin + 1.f); }
                st_bf8(ACT + ro, o[0], o[1]); __builtin_amdgcn_sched_barrier(0); }
    }
};

struct EpiMoeDN {
    bf16* Y; const float* bdn; const unsigned* lent; const float* lgate; const LAS int* tab;
    __device__ __forceinline__ void operator()(EPI_ARGS) const {
        const int lb0 = u.e * 32768 + (u.pm - __builtin_amdgcn_readfirstlane(tab[u.e])) * 256;
        const int rl0 = wr * 64 + fr, col0 = u.pn * 256 + wc * 32 + 8 * fq;
        const float* bb = bdn + (size_t)u.e * 1024 + col0;
        f32x4 bv[2][2];
#pragma unroll
        for (int bj = 0; bj < 2; ++bj) { bv[bj][0] = *(const f32x4*)(bb + bj * 128); bv[bj][1] = *(const f32x4*)(bb + bj * 128 + 4); }
        unsigned entv[2][4]; float gtv[2][4];
#pragma unroll
        for (int ai = 0; ai < 2; ++ai)
#pragma unroll
            for (int m = 0; m < 4; ++m) { const int rl = rl0 + ai * 128 + m * 16; const bool ok = rl < u.nv; entv[ai][m] = ok ? lent[lb0 + rl] : 0u; gtv[ai][m] = ok ? lgate[lb0 + rl] : 0.f; }
        __builtin_amdgcn_sched_barrier(0);
#pragma unroll
        for (int ai = 0; ai < 2; ++ai)
#pragma unroll
            for (int m = 0; m < 4; ++m) { const int rl = rl0 + ai * 128 + m * 16;
                if (rl < u.nv) {
                    const unsigned ent = entv[ai][m]; const float gt = gtv[ai][m];
                    bf16* yo = Y + (size_t)ent * DM + col0;
#pragma unroll
                    for (int bj = 0; bj < 2; ++bj) st_bf8(yo + bj * 128, (acc[ai][bj][m][0] + bv[bj][0]) * gt, (acc[ai][bj][m][1] + bv[bj][1]) * gt); } }
    }
};

struct EpiPleA {
    bf16* PW; float* PSS;
    __device__ __forceinline__ void operator()(EPI_ARGS) const {
        const int row0 = u.pm * 256 + wr * 64 + fr, col0 = u.pn * 256 + wc * 32 + 8 * fq;
#pragma unroll
        for (int ai = 0; ai < 2; ++ai)
#pragma unroll
            for (int m = 0; m < 4; ++m) { const int row = row0 + ai * 128 + m * 16; const size_t ro = (size_t)row * DM;
                float ss = 0.f;
#pragma unroll
                for (int bj = 0; bj < 2; ++bj) { st_bf8(PW + ro + col0 + bj * 128, acc[ai][bj][m][0], acc[ai][bj][m][1]);
#pragma unroll
                    for (int n = 0; n < 2; ++n) { const f32x4 x = acc[ai][bj][m][n]; ss += (x[0] * x[0] + x[1] * x[1]) + (x[2] * x[2] + x[3] * x[3]); } }
                ss += sx<16>(ss); ss = add_x32(ss);
                if (fq == 0) PSS[(size_t)row * 16 + u.pn * 4 + wc] = ss; __builtin_amdgcn_sched_barrier(0); }
    }
};

struct EpiPleFin {
    const float* Hs; float* Out; const bf16* PW; const float* prstd; const float* pn;
    __device__ __forceinline__ void operator()(EPI_ARGS) const {
        const int row0 = u.pm * 256 + wr * 64 + fr, col0 = u.pn * 256 + wc * 32 + 8 * fq;
        f32x4 gv[2][2];
#pragma unroll
        for (int bj = 0; bj < 2; ++bj) { gv[bj][0] = *(const f32x4*)(pn + col0 + bj * 128); gv[bj][1] = *(const f32x4*)(pn + col0 + bj * 128 + 4); }
#pragma unroll
        for (int ai = 0; ai < 2; ++ai)
#pragma unroll
            for (int m = 0; m < 4; ++m) { const int row = row0 + ai * 128 + m * 16; const size_t ro = (size_t)row * DM; const float rs = prstd[row];
#pragma unroll
                for (int bj = 0; bj < 2; ++bj) { const size_t o = ro + col0 + bj * 128;
                    const u32x4 pw = *(const u32x4*)(PW + o); const f32x4 h0 = *(const f32x4*)(Hs + o), h1 = *(const f32x4*)(Hs + o + 4);
                    const f32x4 p0 = (f32x4){bflo(pw.x), bfhi(pw.x), bflo(pw.y), bfhi(pw.y)}, p1 = (f32x4){bflo(pw.z), bfhi(pw.z), bflo(pw.w), bfhi(pw.w)};
                    f32x4 s0, s1;
#pragma unroll
                    for (int j = 0; j < 4; ++j) { s0[j] = sigmoidf_(acc[ai][bj][m][0][j]); s1[j] = sigmoidf_(acc[ai][bj][m][1][j]); }
                    *(f32x4*)(Out + o) = h0 + p0 * rs * gv[bj][0] * s0; *(f32x4*)(Out + o + 4) = h1 + p1 * rs * gv[bj][1] * s1; } }
    }
};
#undef EPI_ARGS
}

struct Ctx {
    LAS unsigned char* lds; int tid, lane, wave, vcu, G, bid;
};
__device__ __forceinline__ Ctx make_ctx(unsigned char* lds_raw, int wave_s) {
    Ctx F; F.lds = (LAS unsigned char*)lds_raw; F.lane = hw_lane(); F.wave = wave_s; F.tid = wave_s * 64 + F.lane;
    F.G = gridDim.x; F.bid = blockIdx.x; F.vcu = (F.G % 8 == 0) ? (F.bid % 8) * (F.G / 8) + F.bid / 8 : F.bid; return F;
}

__device__ __forceinline__ void p0_item(const float* src, int pitch, int k0, int sc0, bf16* dst  , int dpitch, LAS float* scr, int lane) {
#pragma unroll 8
    for (int i = 0; i < 32; ++i) { const int kk = 2 * i + (lane >> 5); scr[kk * 33 + (lane & 31)] = src[(size_t)(k0 + kk) * pitch + sc0 + (lane & 31)]; }
    LDS_WAIT(); asm volatile("" ::: "memory");
    const int c = lane & 7;
#pragma unroll
    for (int j = 0; j < 4; ++j) { const int n = (lane >> 3) + 8 * j; const LAS float* s = scr + (8 * c) * 33 + n;
        u32x4 o; o.x = pk2(s[0 * 33], s[1 * 33]); o.y = pk2(s[2 * 33], s[3 * 33]); o.z = pk2(s[4 * 33], s[5 * 33]); o.w = pk2(s[6 * 33], s[7 * 33]);
        *(GAS u32x4*)(dst + (size_t)n * dpitch + 8 * c) = o; }
    LDS_WAIT(); asm volatile("" ::: "memory");
}

__device__ __forceinline__ void p0_prologue(const Ctx& F, CArgs* A) {
    LAS float* scr = (LAS float*)(F.lds + F.wave * 16384);
    const int gw = F.vcu * NWAVES + F.wave, NGW = F.G * NWAVES;
    unsigned char* ws = A->ws;
    constexpr int IT_GU = 128 * 16 * 64, IT_DN = 128 * 16 * 32, IT_HGIN = 2 * 16 * 128, IT_HGOUT = 2 * 16 * 32, IT_FOXIN = 16 * 128, IT_SQ = 16 * 32,
                  IT_RGIN = 16 * 64, IT_RGAX = 4 * 64, IT_PLE = 4 * 4 * 32, IT_PLEG = 4 * 16 * 32;
    constexpr int C0 = IT_GU, C1 = C0 + IT_DN, C2_ = C1 + IT_HGIN, C3 = C2_ + IT_HGOUT, C4 = C3 + IT_FOXIN, C5 = C4 + IT_SQ  , C6 = C5 + IT_RGIN, C7 = C6 + IT_RGAX,
                  C8 = C7 + IT_SQ  , C9 = C8 + IT_PLE, C10 = C9 + IT_PLEG;
    for (int it = gw; it < C10; it += NGW) {
        if (it < C0) {
            const int mi = it >> 10, r = it & 1023, kb = r >> 6, nb = r & 63, n0 = nb * 32;
            const int pn = n0 >> 8, bj = (n0 >> 7) & 1, c = n0 & 127, sc0 = bj * 1024 + pn * 128 + c;
            p0_item(A->in[I_GU_W] + (size_t)mi * 1024 * 2048, 2048, kb * 64, sc0, (bf16*)(ws + WS_W_GU) + (size_t)mi * 2048 * 1024 + (size_t)n0 * 1024 + kb * 64, 1024, scr, F.lane);
        } else if (it < C1) {
            const int r0 = it - C0, mi = r0 >> 9, r = r0 & 511, kb = r >> 5, n0 = (r & 31) * 32;
            p0_item(A->in[I_DN_W] + (size_t)mi * 1024 * 1024, 1024, kb * 64, n0, (bf16*)(ws + WS_W_DN) + (size_t)mi * 1024 * 1024 + (size_t)n0 * 1024 + kb * 64, 1024, scr, F.lane);
        } else if (it < C2_) {
            const int r0 = it - C1, mi = r0 >> 11, r = r0 & 2047, kb = r >> 7, n0 = (r & 127) * 32;
            p0_item(A->in[I_HG_WIN] + (size_t)mi * 1024 * 4096, 4096, kb * 64, n0, (bf16*)(ws + WS_W_HGIN) + (size_t)mi * 4096 * 1024 + (size_t)n0 * 1024 + kb * 64, 1024, scr, F.lane);
        } else if (it < C3) {
            const int r0 = it - C2_, mi = r0 >> 9, r = r0 & 511, kb = r >> 5, n0 = (r & 31) * 32;
            p0_item(A->in[I_HG_WOUT] + (size_t)mi * 1024 * 1024, 1024, kb * 64, n0, (bf16*)(ws + WS_W_HGOUT) + (size_t)mi * 1024 * 1024 + (size_t)n0 * 1024 + kb * 64, 1024, scr, F.lane);
        } else if (it < C4) {
            const int r = it - C3, kb = r >> 7, n0 = (r & 127) * 32; int sc0 = n0;
            if (n0 < 2048) { const int sec = n0 >> 10, pn = (n0 >> 8) & 3, bj = (n0 >> 7) & 1, wc = (n0 >> 5) & 3; sc0 = sec * 1024 + pn * 256 + wc * 64 + bj * 32; }
            p0_item(A->in[I_FOX_WIN], 4112, kb * 64, sc0, (bf16*)(ws + WS_W_FOXIN) + (size_t)n0 * 1024 + kb * 64, 1024, scr, F.lane);
        } else if (it < C5) {
            const int r = it - C4, kb = r >> 5, n0 = (r & 31) * 32;
            p0_item(A->in[I_FOX_WOUT], 1024, kb * 64, n0, (bf16*)(ws + WS_W_FOXOUT) + (size_t)n0 * 1024 + kb * 64, 1024, scr, F.lane);
        } else if (it < C6) {
            const int r = it - C5, kb = r >> 6, n0 = (r & 63) * 32;
            p0_item(A->in[I_RG_WIN], 2048, kb * 64, n0, (bf16*)(ws + WS_W_RGIN) + (size_t)n0 * 1024 + kb * 64, 1024, scr, F.lane);
        } else if (it < C7) {
            const int r = it - C6, kb = r >> 6, n0 = (r & 63) * 32, pn = n0 >> 8, bj = (n0 >> 7) & 1, c = n0 & 127;
            const float* src = (bj ? A->in[I_RG_WX] : A->in[I_RG_WA]) + (size_t)(pn >> 1) * 256 * 256;
            p0_item(src, 256, kb * 64, (pn & 1) * 128 + c, (bf16*)(ws + WS_W_RGAX) + (size_t)n0 * 256 + kb * 64, 256, scr, F.lane);
        } else if (it < C8) {
            const int r = it - C7, kb = r >> 5, n0 = (r & 31) * 32;
            p0_item(A->in[I_RG_WOUT], 1024, kb * 64, n0, (bf16*)(ws + WS_W_RGOUT) + (size_t)n0 * 1024 + kb * 64, 1024, scr, F.lane);
        } else if (it < C9) {
            const int r0 = it - C8, mi = r0 >> 7, r = r0 & 127, kb = r >> 5, n0 = (r & 31) * 32;
            p0_item(A->in[I_PLE_W] + (size_t)mi * 256 * 1024, 1024, kb * 64, n0, (bf16*)(ws + WS_W_PLE) + (size_t)mi * 1024 * 256 + (size_t)n0 * 256 + kb * 64, 256, scr, F.lane);
        } else {
            const int r0 = it - C9, mi = r0 >> 9, r = r0 & 511, kb = r >> 5, n0 = (r & 31) * 32;
            p0_item(A->in[I_PLE_GW] + (size_t)mi * 1024 * 1024, 1024, kb * 64, n0, (bf16*)(ws + WS_W_PLEG) + (size_t)mi * 1024 * 1024 + (size_t)n0 * 1024 + kb * 64, 1024, scr, F.lane);
        }
    }
    { const size_t n8 = (size_t)DEPTH * M * PLED / 8; const size_t gt = (size_t)F.vcu * NTHR + F.tid, NT = (size_t)F.G * NTHR;
      const f32x4* src = (const f32x4*)A->in[I_P]; u32x4* dst = (u32x4*)(ws + WS_PB);
      for (size_t i = gt; i < n8; i += NT) { const f32x4 a = src[2 * i], b = src[2 * i + 1]; u32x4 o; o.x = pk2(a[0], a[1]); o.y = pk2(a[2], a[3]); o.z = pk2(b[0], b[1]); o.w = pk2(b[2], b[3]); dst[i] = o; } }
    if (F.bid == 0) {
        float* sm = (float*)(ws + WS_SMALL);
        for (int d = F.tid; d < DM; d += NTHR) {
            const float* lp = A->in[I_HG_LB]; const float a0 = lp[d], a1 = lp[DM + d], a2 = lp[2 * DM + d], a3 = lp[3 * DM + d];
            const float mx = fmaxf(fmaxf(a0, a1), fmaxf(a2, a3)); const float e0 = __expf(a0 - mx), e1 = __expf(a1 - mx), e2 = __expf(a2 - mx), e3 = __expf(a3 - mx);
            const float inv = 1.f / (e0 + e1 + e2 + e3);
            sm[SM_LB0 / 4 + d] = 0.f; sm[SM_LB3 / 4 + d] = (e1 + e2 + e3) * inv;
            const float lam = A->in[I_RG_LAM][d]; const float sp = (-lam > 15.f) ? -lam : log1pf(__expf(-lam)); sm[SM_SP8 / 4 + d] = 8.f * sp;
        }
    }
}

__device__ __forceinline__ float row_load_rstd(const float* row, int lane, f32x4 (&v)[4]) {
    const GAS f32x4* xr = (const GAS f32x4*)row + lane; float s = 0.f;
#pragma unroll
    for (int j = 0; j < 4; ++j) { v[j] = xr[64 * j]; s += (v[j].x * v[j].x + v[j].y * v[j].y) + (v[j].z * v[j].z + v[j].w * v[j].w); }
    return __builtin_amdgcn_rsqf(wave_sum(s) * (1.f / DM) + EPS);
}
__device__ __forceinline__ void row_store_bf16(bf16* orow, int lane, const f32x4 (&v)[4], float rstd, const f32x4 (&g)[4]) {
    GAS u32x2* o8 = (GAS u32x2*)orow + lane;
#pragma unroll
    for (int j = 0; j < 4; ++j) { u32x2 w; w.x = pk2(v[j].x * rstd * g[j].x, v[j].y * rstd * g[j].y); w.y = pk2(v[j].z * rstd * g[j].z, v[j].w * rstd * g[j].w); o8[64 * j] = w; }
}
__device__ __forceinline__ void t1_plain(const Ctx& F, const float* H, const float* gain, bf16* XN) {
    const int gw = F.vcu * NWAVES + F.wave, NGW = F.G * NWAVES;
    f32x4 g[4];
#pragma unroll
    for (int j = 0; j < 4; ++j) g[j] = ((const f32x4*)gain)[F.lane + 64 * j];
    for (int m = gw; m < M; m += NGW) { f32x4 v[4]; const float rstd = row_load_rstd(H + (size_t)m * DM, F.lane, v); row_store_bf16(XN + (size_t)m * DM, F.lane, v, rstd, g); }
}

template <int NE> __device__ __forceinline__ int w_swz(int k) { return NE == 32 ? ((k >> 1) & 7) : ((k >> 2) & 3); }
template <int NE> __device__ __forceinline__ void load_w_lds(const Ctx& F, const float* W, int pitch, int col0) {
    constexpr int NQ = NE / 4; LAS float* wl = (LAS float*)F.lds;
    for (int idx = F.tid; idx < DM * NQ; idx += NTHR) { const int k = idx / NQ, q = idx % NQ; const f32x4 v = *(const f32x4*)(W + (size_t)k * pitch + col0 + 4 * q);
        *(LAS f32x4*)(wl + k * NE + ((q ^ w_swz<NE>(k)) * 4)) = v; }
}
template <int N, int DIST> struct RS { static __device__ __forceinline__ float run(const float (&a)[N], int lane) {
    float b[N / 2];
    if constexpr (DIST == 32) {
#pragma unroll
        for (int i = 0; i < N / 2; ++i) { float lo = a[i], hi = a[i + N / 2]; swap32(lo, hi); b[i] = lo + hi; }
    } else { const bool up = (lane & DIST) != 0;
#pragma unroll
        for (int i = 0; i < N / 2; ++i) { const float keep = up ? a[i + N / 2] : a[i], send = up ? a[i] : a[i + N / 2]; b[i] = keep + sx<DIST>(send); } }
    return RS<N / 2, DIST / 2>::run(b, lane); } };
template <int DIST> struct RS<1, DIST> { static __device__ __forceinline__ float run(const float (&a)[1], int lane) { float v = a[0];
    if constexpr (DIST >= 16) v += sx<16>(v); if constexpr (DIST >= 8) v += sx<8>(v); if constexpr (DIST >= 4) v += sx<4>(v); if constexpr (DIST >= 2) v += sx<2>(v); v += sx<1>(v); return v; } };
__device__ __forceinline__ void rows2_rstd(const float* r0p, const float* r1p, int lane, float& rs0, float& rs1) {
    float s0 = 0.f, s1 = 0.f;
#pragma unroll
    for (int jj = 0; jj < 16; ++jj) { const float a = r0p[lane + 64 * jj], b = r1p[lane + 64 * jj]; s0 += a * a; s1 += b * b; }
    rs0 = __builtin_amdgcn_rsqf(wave_sum(s0) * (1.f / DM) + EPS); rs1 = __builtin_amdgcn_rsqf(wave_sum(s1) * (1.f / DM) + EPS);
}
template <int NE> __device__ __forceinline__ void rows2_norm_proj(const LAS float* wl, const float* r0p, const float* r1p, const float* gain, bf16* o0, bf16* o1, float rs0, float rs1, int lane, float& r0, float& r1) {
    constexpr int NQ = NE / 4; float a0[NE], a1[NE];
#pragma unroll
    for (int e = 0; e < NE; ++e) { a0[e] = 0.f; a1[e] = 0.f; }
    const int sw = w_swz<NE>(lane);
#pragma unroll 2
    for (int jj = 0; jj < 16; ++jj) { const int k = lane + 64 * jj; const float gk = gain[k]; const float x0 = r0p[k] * rs0 * gk, x1 = r1p[k] * rs1 * gk;
        o0[k] = (bf16)f2bf(x0); o1[k] = (bf16)f2bf(x1);
        const LAS float* wrow = wl + k * NE;
#pragma unroll
        for (int q = 0; q < NQ; ++q) { const f32x4 w = *(const LAS f32x4*)(wrow + ((q ^ sw) * 4));
#pragma unroll
            for (int c = 0; c < 4; ++c) { a0[4 * q + c] += x0 * w[c]; a1[4 * q + c] += x1 * w[c]; } } }
    r0 = RS<NE, 32>::run(a0, lane); r1 = RS<NE, 32>::run(a1, lane);
}

__device__ __forceinline__ void t1_fox(const Ctx& F, const float* H, const float* gain, bf16* XN, const float* Wfox, const float* fbias, float* LSIG) {
    load_w_lds<16>(F, Wfox, 4112, 4096);
    const float fb = fbias[F.lane >> 2];
    __syncthreads();
    for (int rb = F.bid; rb < M / 128; rb += F.G) {
        const int rbase = rb * 128 + F.wave * 16;
        for (int pr = 0; pr < 8; ++pr) { const int m0 = rbase + 2 * pr;
            const float* r0p = H + (size_t)m0 * DM; const float* r1p = r0p + DM; float rs0, rs1, r0, r1; rows2_rstd(r0p, r1p, F.lane, rs0, rs1);
            rows2_norm_proj<16>((const LAS float*)F.lds, r0p, r1p, gain, XN + (size_t)m0 * DM, XN + (size_t)(m0 + 1) * DM, rs0, rs1, F.lane, r0, r1);
            if ((F.lane & 3) == 0) {
                const float z0 = r0 + fb, z1 = r1 + fb;
                LSIG[(size_t)m0 * 16 + (F.lane >> 2)] = fminf(z0, 0.f) - log1pf(__expf(-fabsf(z0)));
                LSIG[(size_t)(m0 + 1) * 16 + (F.lane >> 2)] = fminf(z1, 0.f) - log1pf(__expf(-fabsf(z1))); } } }
    __syncthreads();
}

__device__ __forceinline__ void t2_router(const Ctx& F, const float* H, const float* gain, bf16* XN, const float* Wr, const float* br, gu32* cnt, unsigned* LENT, float* LGATE) {
    LAS int* ent_e = (LAS int*)(F.lds + LDSX_OFF); LAS float* ent_g = (LAS float*)(F.lds + LDSX_OFF + 2048); LAS int* ent_li = (LAS int*)(F.lds + LDSX_OFF + 4096);
    LAS int* hist = (LAS int*)(F.lds + LDSX_OFF + 6144); LAS int* base = (LAS int*)(F.lds + LDSX_OFF + 6144 + 128);
    load_w_lds<32>(F, Wr, 32, 0);
    const float bias = br[F.lane >> 1];
    for (int rb = F.bid; rb < M / 128; rb += F.G) {
        if (F.tid < 32) hist[F.tid] = 0;
        __syncthreads();
        const int rl0 = F.wave * 16;
        for (int pr = 0; pr < 8; ++pr) { const int rl = rl0 + 2 * pr, m0 = rb * 128 + rl;
            const float* r0p = H + (size_t)m0 * DM; const float* r1p = r0p + DM; float rs0, rs1, r0, r1; rows2_rstd(r0p, r1p, F.lane, rs0, rs1);
            rows2_norm_proj<32>((const LAS float*)F.lds, r0p, r1p, gain, XN + (size_t)m0 * DM, XN + (size_t)(m0 + 1) * DM, rs0, rs1, F.lane, r0, r1);
#pragma unroll
            for (int rr = 0; rr < 2; ++rr) {
                float val = (rr == 0 ? r0 : r1) + bias; float tv[4]; int ti[4];
#pragma unroll
                for (int j = 0; j < 4; ++j) { const float mx = wave_max(val); const unsigned long long bl = __ballot(val == mx); const int first = __ffsll((long long)bl) - 1;
                    tv[j] = mx; ti[j] = first >> 1; if ((F.lane >> 1) == ti[j]) val = -INFINITY; }
                const float e1 = __expf(tv[1] - tv[0]), e2 = __expf(tv[2] - tv[0]), e3 = __expf(tv[3] - tv[0]); const float inv = 1.f / (1.f + e1 + e2 + e3);
                if (F.lane < 4) { const int j = F.lane; const int e = j == 0 ? ti[0] : j == 1 ? ti[1] : j == 2 ? ti[2] : ti[3]; const float gt = (j == 0 ? 1.f : j == 1 ? e1 : j == 2 ? e2 : e3) * inv;
                    const int li = __hip_atomic_fetch_add(hist + e, 1, __ATOMIC_RELAXED, __HIP_MEMORY_SCOPE_WORKGROUP);
                    const int slot = (rl + rr) * 4 + j; ent_e[slot] = e; ent_g[slot] = gt; ent_li[slot] = li; }
            } }
        __syncthreads();
        if (F.tid < 32) base[F.tid] = (int)__hip_atomic_fetch_add(cnt + F.tid, (unsigned)hist[F.tid], RLX_AGENT);
        __syncthreads();
        { const int t = F.tid, e = ent_e[t], pos = base[e] + ent_li[t]; LENT[(size_t)e * 32768 + pos] = (unsigned)((rb * 128 + (t >> 2)) * 4 + (t & 3)); LGATE[(size_t)e * 32768 + pos] = ent_g[t]; }
        __syncthreads();
    }
}

__device__ __forceinline__ void t3_combine(const Ctx& F, float* H, const bf16* Y, const float* gain, bf16* GN, const float* PSS, float* PRSTD) {
    const int gw = F.vcu * NWAVES + F.wave, NGW = F.G * NWAVES;
    f32x4 g[4];
#pragma unroll
    for (int j = 0; j < 4; ++j) g[j] = ((const f32x4*)gain)[F.lane + 64 * j];
    for (int m = gw; m < M; m += NGW) {
        GAS f32x4* hr = (GAS f32x4*)(H + (size_t)m * DM) + F.lane; f32x4 v[4]; float s = 0.f;
#pragma unroll
        for (int j = 0; j < 4; ++j) { v[j] = hr[64 * j];
#pragma unroll
            for (int k = 0; k < 4; ++k) { const u32x2 w = ((const GAS u32x2*)(Y + ((size_t)m * 4 + k) * DM))[F.lane + 64 * j]; v[j].x += bflo(w.x); v[j].y += bfhi(w.x); v[j].z += bflo(w.y); v[j].w += bfhi(w.y); }
            hr[64 * j] = v[j]; s += (v[j].x * v[j].x + v[j].y * v[j].y) + (v[j].z * v[j].z + v[j].w * v[j].w); }
        const float rstd = __builtin_amdgcn_rsqf(wave_sum(s) * (1.f / DM) + EPS);
        row_store_bf16(GN + (size_t)m * DM, F.lane, v, rstd, g);
        float ps = F.lane < 16 ? PSS[(size_t)m * 16 + F.lane] : 0.f; ps = wave_sum(ps);
        if (F.lane == 0) PRSTD[m] = __builtin_amdgcn_rsqf(ps * (1.f / DM) + EPS);
    }
}

__device__ __forceinline__ void rg_conv(const Ctx& F, const bf16* U, const float* cw, const float* cb, bf16* UC) {
    const int cg = (F.tid & 127) * 8, rq = F.tid >> 7;
    float w[4][8], b[8];
#pragma unroll
    for (int j = 0; j < 8; ++j) { b[j] = cb[cg + j];
#pragma unroll
        for (int t = 0; t < 4; ++t) w[t][j] = cw[t * DM + cg + j]; }
    for (int rb = F.bid; rb < M / 128; rb += F.G) {
        const int r0 = rb * 128 + rq * 32, t0 = r0 & (SEQ - 1);
        float p[3][8];
#pragma unroll
        for (int k = 0; k < 3; ++k) { const int dt = 3 - k;
            if (t0 - dt >= 0) { const u32x4 x = *(const u32x4*)(U + (size_t)(r0 - dt) * DM + cg); p[k][0] = bflo(x.x); p[k][1] = bfhi(x.x); p[k][2] = bflo(x.y); p[k][3] = bfhi(x.y); p[k][4] = bflo(x.z); p[k][5] = bfhi(x.z); p[k][6] = bflo(x.w); p[k][7] = bfhi(x.w); }
            else {
#pragma unroll
                for (int j = 0; j < 8; ++j) p[k][j] = 0.f; } }
#pragma unroll 4
        for (int r = 0; r < 32; ++r) { const u32x4 x = *(const u32x4*)(U + (size_t)(r0 + r) * DM + cg);
            float c[8] = {bflo(x.x), bfhi(x.x), bflo(x.y), bfhi(x.y), bflo(x.z), bfhi(x.z), bflo(x.w), bfhi(x.w)}; float o[8];
#pragma unroll
            for (int j = 0; j < 8; ++j) { o[j] = b[j] + p[0][j] * w[0][j] + p[1][j] * w[1][j] + p[2][j] * w[2][j] + c[j] * w[3][j]; p[0][j] = p[1][j]; p[1][j] = p[2][j]; p[2][j] = c[j]; }
            u32x4 ow; ow.x = pk2(o[0], o[1]); ow.y = pk2(o[2], o[3]); ow.z = pk2(o[4], o[5]); ow.w = pk2(o[6], o[7]); *(u32x4*)(UC + (size_t)(r0 + r) * DM + cg) = ow; }
    }
}
__device__ __forceinline__ void rg_scan1(const Ctx& F, const float* A, const float* X, float* SC) {
    const int c = 2 * F.tid;
    for (int rb = F.bid; rb < M / 128; rb += F.G) {
        float p0 = 1.f, p1 = 1.f, h0 = 0.f, h1 = 0.f; const size_t o = (size_t)rb * 128 * DM + c;
#pragma unroll 8
        for (int r = 0; r < 128; ++r) { const f32x2 a = *(const f32x2*)(A + o + (size_t)r * DM), x = *(const f32x2*)(X + o + (size_t)r * DM); h0 = a.x * h0 + x.x; h1 = a.y * h1 + x.y; p0 *= a.x; p1 *= a.y; }
        *(f32x4*)(SC + ((size_t)rb * DM + c) * 2) = (f32x4){p0, h0, p1, h1};
    }
}
__device__ __forceinline__ void rg_scan2(const Ctx& F, const float* A, const float* X, const float* SC, const bf16* GATE, bf16* OUT) {
    const int c = 2 * F.tid;
    for (int rb = F.bid; rb < M / 128; rb += F.G) {
        const int cb = rb & 63, b0 = rb - cb; float h0 = 0.f, h1 = 0.f;
        for (int cc = 0; cc < cb; ++cc) { const f32x4 s = *(const f32x4*)(SC + ((size_t)(b0 + cc) * DM + c) * 2); h0 = s.x * h0 + s.y; h1 = s.z * h1 + s.w; }
        const size_t o = (size_t)rb * 128 * DM + c;
#pragma unroll 8
        for (int r = 0; r < 128; ++r) { const f32x2 a = *(const f32x2*)(A + o + (size_t)r * DM), x = *(const f32x2*)(X + o + (size_t)r * DM); const unsigned gw = *(const unsigned*)(GATE + o + (size_t)r * DM);
            h0 = a.x * h0 + x.x; h1 = a.y * h1 + x.y; *(unsigned*)(OUT + o + (size_t)r * DM) = pk2(h0 * bflo(gw), h1 * bfhi(gw)); }
    }
}

__device__ __forceinline__ void fox_cum(const Ctx& F, const float* LSIG, float* FCUM, bf16* KC) {
    LAS float* wt = (LAS float*)(F.lds + LDSX_OFF);
    for (int bh = F.bid; bh < NB * FOXH; bh += F.G) {
        const int b = bh >> 4, hd = bh & 15, s0 = F.tid * 16; float v[16]; float run = 0.f;
#pragma unroll
        for (int i = 0; i < 16; ++i) { run += LSIG[((size_t)b * SEQ + s0 + i) * 16 + hd]; v[i] = run; }
        float inc = run;
#pragma unroll
        for (int o = 1; o < 64; o <<= 1) { const float t = __builtin_bit_cast(float, __builtin_amdgcn_ds_bpermute((F.lane - o) << 2, __builtin_bit_cast(int, inc))); if (F.lane >= o) inc += t; }
        if (F.lane == 63) wt[F.wave] = inc;
        __syncthreads();
        float off = inc - run;
        for (int w = 0; w < F.wave; ++w) off += wt[w];
        __syncthreads();
#pragma unroll
        for (int i = 0; i < 16; ++i) { const float c = v[i] + off; FCUM[(size_t)bh * SEQ + s0 + i] = c;
            const float nb = -c * 1.4426950408889634f; const unsigned h = f2bf(nb); const float r1 = nb - bf2f((unsigned short)h); const unsigned mm = f2bf(r1); const float r2 = r1 - bf2f((unsigned short)mm); const unsigned lo = f2bf(r2);
            u32x4 w; w.x = h | (mm << 16); w.y = lo | (0x3F80u << 16); w.z = 0x3F80u | (0x3F80u << 16); w.w = 0u;
            *(u32x4*)(KC + ((size_t)bh * SEQ + s0 + i) * 8) = w; }
    }
}

constexpr int HG_P128 = 136, HG_P64 = 72;
__device__ __forceinline__ void unpack8(const u32x4 w, float (&f)[8]) { f[0] = bflo(w.x); f[1] = bfhi(w.x); f[2] = bflo(w.y); f[3] = bfhi(w.y); f[4] = bflo(w.z); f[5] = bfhi(w.z); f[6] = bflo(w.w); f[7] = bfhi(w.w); }
__device__ __forceinline__ int crow32(int r, int hi) { return (r & 3) + 8 * (r >> 2) + 4 * hi; }

__device__ __forceinline__ void hg_unit_a(const Ctx& F, int u, float* LF, const bf16* Kk, const bf16* V, float* GT, float* DEC) {
    LAS float* CUM = (LAS float*)F.lds; LAS float* TOT = (LAS float*)(F.lds + 32768);
    LAS bf16* KET = (LAS bf16*)(F.lds + 36864); LAS bf16* VT = (LAS bf16*)(F.lds + 36864 + 128 * HG_P64 * 2);
    const int hd = u & 7, bc = u >> 3; const size_t m0 = (size_t)bc * 64; const int t = F.tid, row = t >> 3, c0 = (t & 7) * 16;
    const size_t go = (m0 + row) * DM + hd * 128 + c0;
    f32x4 lf[4];
#pragma unroll
    for (int j = 0; j < 4; ++j) lf[j] = *(const f32x4*)(LF + go + 4 * j);
    const u32x4 kw0 = *(const u32x4*)(Kk + go), kw1 = *(const u32x4*)(Kk + go + 8), vw0 = *(const u32x4*)(V + go), vw1 = *(const u32x4*)(V + go + 8);
#pragma unroll
    for (int j = 0; j < 4; ++j) *(LAS f32x4*)(CUM + row * 128 + c0 + 4 * j) = lf[j];
    __syncthreads();
    { const int d = t & 127, qd = t >> 7; float run = 0.f;
#pragma unroll
      for (int r = 0; r < 16; ++r) { run += CUM[(qd * 16 + r) * 128 + d]; CUM[(qd * 16 + r) * 128 + d] = run; }
      TOT[qd * 128 + d] = run;
      __syncthreads();
      float off = 0.f; for (int q = 0; q < qd; ++q) off += TOT[q * 128 + d];
      if (qd > 0) {
#pragma unroll
          for (int r = 0; r < 16; ++r) CUM[(qd * 16 + r) * 128 + d] += off; }
      __syncthreads();
      if (t < 128) DEC[(size_t)u * 128 + t] = fexp(CUM[63 * 128 + t]); }
    { float kf[16], vf[16]; unpack8(kw0, *(float(*)[8])&kf[0]); unpack8(kw1, *(float(*)[8])&kf[8]); unpack8(vw0, *(float(*)[8])&vf[0]); unpack8(vw1, *(float(*)[8])&vf[8]);
#pragma unroll
      for (int j = 0; j < 4; ++j) { const f32x4 cu = *(const LAS f32x4*)(CUM + row * 128 + c0 + 4 * j), cl = *(const LAS f32x4*)(CUM + 63 * 128 + c0 + 4 * j);
          *(f32x4*)(LF + go + 4 * j) = cu;
#pragma unroll
          for (int i = 0; i < 4; ++i) { const int d = c0 + 4 * j + i; KET[d * HG_P64 + row] = (bf16)f2bf(kf[4 * j + i] * fexp(cl[i] - cu[i])); VT[d * HG_P64 + row] = (bf16)f2bf(vf[4 * j + i]); } } }
    __syncthreads();
    { const int w = F.wave, vb = w >> 1, i = F.lane & 31, hi = F.lane >> 5; f32x16 acc0 = {}, acc1 = {};
#pragma unroll
      for (int ks = 0; ks < 4; ++ks) { const bf16x8 a = *(const LAS bf16x8*)(VT + (vb * 32 + i) * HG_P64 + 16 * ks + 8 * hi);
          const bf16x8 b0 = *(const LAS bf16x8*)(KET + ((2 * (w & 1)) * 32 + i) * HG_P64 + 16 * ks + 8 * hi), b1 = *(const LAS bf16x8*)(KET + ((2 * (w & 1) + 1) * 32 + i) * HG_P64 + 16 * ks + 8 * hi);
          acc0 = __builtin_amdgcn_mfma_f32_32x32x16_bf16(a, b0, acc0, 0, 0, 0); acc1 = __builtin_amdgcn_mfma_f32_32x32x16_bf16(a, b1, acc1, 0, 0, 0); }
      float* g = GT + (size_t)u * 16384;
#pragma unroll
      for (int r = 0; r < 16; ++r) { const int v = vb * 32 + crow32(r, hi); g[v * 128 + (2 * (w & 1)) * 32 + i] = acc0[r]; g[v * 128 + (2 * (w & 1) + 1) * 32 + i] = acc1[r]; } }
    __syncthreads();
}

__device__ __forceinline__ void hg_scan_b(const Ctx& F, const float* GT, const float* DEC, bf16* ST) {
    for (int w = F.bid; w < 256; w += F.G) {
        const int bh = w >> 3, vb = w & 7, b = bh >> 3, hd = bh & 7, v = vb * 16 + (F.tid >> 5), d4 = (F.tid & 31) * 4;
        f32x4 s = {0.f, 0.f, 0.f, 0.f};
#pragma unroll 4
        for (int c = 0; c < 128; ++c) { const size_t u = (size_t)(b * 128 + c) * 8 + hd; const size_t o = (u * 128 + v) * 128 + d4;
            const f32x4 g = *(const f32x4*)(GT + o), dc = *(const f32x4*)(DEC + u * 128 + d4);
            u32x2 wv; wv.x = pk2(s.x, s.y); wv.y = pk2(s.z, s.w); *(u32x2*)(ST + o) = wv;
            s = dc * s + g; }
    }
}

__device__ __forceinline__ void hg_unit_c(const Ctx& F, int u, const float* CUMG, const bf16* Q, const bf16* Kk, const bf16* V, const bf16* G, const bf16* ST, const float* gnorm, bf16* OUT) {
    LAS float* CUM = (LAS float*)F.lds;
    LAS bf16* QD = (LAS bf16*)(F.lds + 32768); LAS bf16* KD = (LAS bf16*)(F.lds + 50176); LAS bf16* Q2 = (LAS bf16*)(F.lds + 67584);
    LAS bf16* Q1 = (LAS bf16*)(F.lds + 84992); LAS bf16* K1 = (LAS bf16*)(F.lds + 93696); LAS bf16* VT = (LAS bf16*)(F.lds + 102400); LAS bf16* P = (LAS bf16*)(F.lds + 120832);
    LAS float* O = (LAS float*)F.lds;
    const int hd = u & 7, bc = u >> 3; const size_t m0 = (size_t)bc * 64; const int t = F.tid, row = t >> 3, c0 = (t & 7) * 16;
    const size_t go = (m0 + row) * DM + hd * 128 + c0;
    const int w = F.wave, lane = F.lane;
    f32x4 cu[4];
#pragma unroll
    for (int j = 0; j < 4; ++j) cu[j] = *(const f32x4*)(CUMG + go + 4 * j);
    const u32x4 qw0 = *(const u32x4*)(Q + go), qw1 = *(const u32x4*)(Q + go + 8), kw0 = *(const u32x4*)(Kk + go), kw1 = *(const u32x4*)(Kk + go + 8), vw0 = *(const u32x4*)(V + go), vw1 = *(const u32x4*)(V + go + 8);
    const int tb = w >> 2, vb = w & 3, li = lane & 31, hi = lane >> 5;
    bf16x8 sfr[8];
    { const bf16* sp = ST + ((size_t)u * 128 + vb * 32 + li) * 128 + 8 * hi;
#pragma unroll
      for (int ks = 0; ks < 8; ++ks) sfr[ks] = *(const bf16x8*)(sp + 16 * ks); }
#pragma unroll
    for (int j = 0; j < 4; ++j) *(LAS f32x4*)(CUM + row * 128 + c0 + 4 * j) = cu[j];
    { float vf[16]; unpack8(vw0, *(float(*)[8])&vf[0]); unpack8(vw1, *(float(*)[8])&vf[8]);
#pragma unroll
      for (int i = 0; i < 16; ++i) VT[(c0 + i) * HG_P64 + row] = (bf16)f2bf(vf[i]); }
    for (int i = t; i < 64 * HG_P64 / 8; i += NTHR) *(LAS u32x4*)(P + i * 8) = (u32x4){0u, 0u, 0u, 0u};
    __syncthreads();
    { float qf[16], kf[16]; unpack8(qw0, *(float(*)[8])&qf[0]); unpack8(qw1, *(float(*)[8])&qf[8]); unpack8(kw0, *(float(*)[8])&kf[0]); unpack8(kw1, *(float(*)[8])&kf[8]);
      const int sub = row >> 5, midr = sub * 32 + 15;
      float oqd[16], okd[16], oq2[16], ox[16];
#pragma unroll
      for (int j = 0; j < 4; ++j) { const f32x4 md = *(const LAS f32x4*)(CUM + midr * 128 + c0 + 4 * j), b1 = *(const LAS f32x4*)(CUM + 31 * 128 + c0 + 4 * j);
#pragma unroll
          for (int i = 0; i < 4; ++i) { const float c = cu[j][i]; const int e = 4 * j + i;
              oqd[e] = qf[e] * fexp(c - md[i]); okd[e] = kf[e] * fexp(md[i] - c); oq2[e] = qf[e] * fexp(c);
              ox[e] = sub ? qf[e] * fexp(c - b1[i]) : kf[e] * fexp(b1[i] - c); } }
#define HG_ST16(dst, src) do { u32x4 a_, b_; a_.x = pk2(src[0], src[1]); a_.y = pk2(src[2], src[3]); a_.z = pk2(src[4], src[5]); a_.w = pk2(src[6], src[7]); b_.x = pk2(src[8], src[9]); b_.y = pk2(src[10], src[11]); b_.z = pk2(src[12], src[13]); b_.w = pk2(src[14], src[15]); \
          *(LAS u32x4*)(dst) = a_; *(LAS u32x4*)((dst) + 8) = b_; } while (0)
      HG_ST16(QD + row * HG_P128 + c0, oqd); HG_ST16(KD + row * HG_P128 + c0, okd); HG_ST16(Q2 + row * HG_P128 + c0, oq2);
      if (sub) { HG_ST16(Q1 + (row - 32) * HG_P128 + c0, ox); } else { HG_ST16(K1 + row * HG_P128 + c0, ox); }
#undef HG_ST16
    }
    __syncthreads();
    { const int fr = lane & 15, kg = lane >> 4;
      for (int bi = w; bi < 10; bi += 8) {
          int I = 0, J = 0; { int k = bi; while (k > I) { k -= I + 1; ++I; } J = k; }
          const bool diag = (I >> 1) == (J >> 1);
          const LAS bf16* ap = diag ? QD + (16 * I + fr) * HG_P128 : Q1 + (16 * I - 32 + fr) * HG_P128;
          const LAS bf16* bp = diag ? KD + (16 * J + fr) * HG_P128 : K1 + (16 * J + fr) * HG_P128;
          f32x4 acc = {0.f, 0.f, 0.f, 0.f};
#pragma unroll
          for (int ks = 0; ks < 4; ++ks) { const bf16x8 a = *(const LAS bf16x8*)(ap + 32 * ks + 8 * kg), b = *(const LAS bf16x8*)(bp + 32 * ks + 8 * kg); acc = __builtin_amdgcn_mfma_f32_16x16x32_bf16(a, b, acc, 0, 0, 0); }
#pragma unroll
          for (int r = 0; r < 4; ++r) { const int tt = 16 * I + 4 * kg + r, ss = 16 * J + fr; const float x = (I == J && ss > tt) ? 0.f : acc[r]; P[tt * HG_P64 + ss] = (bf16)f2bf(x); } } }
    __syncthreads();
    f32x16 o = {};
    {
#pragma unroll
      for (int ks = 0; ks < 4; ++ks) { const bf16x8 a = *(const LAS bf16x8*)(P + (tb * 32 + li) * HG_P64 + 16 * ks + 8 * hi), b = *(const LAS bf16x8*)(VT + (vb * 32 + li) * HG_P64 + 16 * ks + 8 * hi);
          o = __builtin_amdgcn_mfma_f32_32x32x16_bf16(a, b, o, 0, 0, 0); }
#pragma unroll
      for (int ks = 0; ks < 8; ++ks) { const bf16x8 a = *(const LAS bf16x8*)(Q2 + (tb * 32 + li) * HG_P128 + 16 * ks + 8 * hi); o = __builtin_amdgcn_mfma_f32_32x32x16_bf16(a, sfr[ks], o, 0, 0, 0); } }
    __syncthreads();
#pragma unroll
    for (int r = 0; r < 16; ++r) O[(tb * 32 + crow32(r, hi)) * 132 + vb * 32 + li] = o[r];
    __syncthreads();
    { float x[16]; float ss = 0.f;
#pragma unroll
      for (int j = 0; j < 4; ++j) { const f32x4 v4 = *(const LAS f32x4*)(O + row * 132 + c0 + 4 * j); x[4 * j] = v4.x; x[4 * j + 1] = v4.y; x[4 * j + 2] = v4.z; x[4 * j + 3] = v4.w; ss += (v4.x * v4.x + v4.y * v4.y) + (v4.z * v4.z + v4.w * v4.w); }
      ss += sx<1>(ss); ss += sx<2>(ss); ss += sx<4>(ss);
      const float rstd = __builtin_amdgcn_rsqf(ss * (1.f / 128.f) + EPS);
      const u32x4 gw0 = *(const u32x4*)(G + go), gw1 = *(const u32x4*)(G + go + 8); float gf[16]; unpack8(gw0, *(float(*)[8])&gf[0]); unpack8(gw1, *(float(*)[8])&gf[8]);
      float y[16];
#pragma unroll
      for (int i = 0; i < 16; ++i) y[i] = x[i] * rstd * gnorm[c0 + i] * gf[i];
      u32x4 a_, b_; a_.x = pk2(y[0], y[1]); a_.y = pk2(y[2], y[3]); a_.z = pk2(y[4], y[5]); a_.w = pk2(y[6], y[7]); b_.x = pk2(y[8], y[9]); b_.y = pk2(y[10], y[11]); b_.z = pk2(y[12], y[13]); b_.w = pk2(y[14], y[15]);
      *(u32x4*)(OUT + go) = a_; *(u32x4*)(OUT + go + 8) = b_; }
    __syncthreads();
}
namespace attn_body {
using bf16=__hip_bfloat16;
using bf16x8=__attribute__((ext_vector_type(8)))short;
using s16x4=__attribute__((ext_vector_type(4)))short;
using f32x16=__attribute__((ext_vector_type(16)))float;
using u32x4=__attribute__((ext_vector_type(4)))unsigned;
constexpr int BATCH=4,NHEAD=16,SEQ=8192,D=64,DM=NHEAD*D;
constexpr int NW=8,QBLK=32,QB=QBLK*NW,KVBLK=64,NQB=SEQ/QB;
constexpr int ATTN_PITCH=DM, ATTN_UNIT_ROWS=QB;
__device__ __forceinline__ int crow(int r,int hi){return (r&3)+8*(r>>2)+4*hi;}
#define SBAR() __builtin_amdgcn_sched_barrier(0)
__device__ __forceinline__ void cmask(f32x16&p0,f32x16&p1,int jb,int qrel,int hi){
  const float NEG=-INFINITY; int kb=64*jb+4*hi;
  #pragma unroll
  for(int r=0;r<16;++r){int kv=kb+(r&3)+8*(r>>2); if(kv>qrel)p0[r]=NEG; if(kv+32>qrel)p1[r]=NEG;}
}

constexpr int NSLOT=3, SLOTB=8192;
constexpr int CSLOTB=2048;
constexpr int LDS_K=0, LDS_V=NSLOT*SLOTB, LDS_C=2*NSLOT*SLOTB, LDS_WS=LDS_C+NSLOT*CSLOTB, LDS_OST=LDS_WS+NW*64*4, LDS_BYTES=LDS_OST+NW*4096;
constexpr float C2=0.125f*1.4426950408889634f;
__device__ __forceinline__ void glds16(const void*gsrc,unsigned lds_dst){unsigned keep;
  asm volatile("s_mov_b32 %0, m0\n\ts_mov_b32 m0, %2\n\ts_nop 0\n\tglobal_load_lds_dwordx4 %1, off\n\ts_mov_b32 m0, %0":"=&s"(keep):"v"(gsrc),"s"(lds_dst):"memory");}
__device__ __forceinline__ void glds16s(const void*sbase,unsigned voff,unsigned lds_dst){unsigned keep;
  asm volatile("s_mov_b32 %0, m0\n\ts_mov_b32 m0, %3\n\ts_nop 0\n\tglobal_load_lds_dwordx4 %1, %2\n\ts_mov_b32 m0, %0":"=&s"(keep):"v"(voff),"s"(sbase),"s"(lds_dst):"memory");}
__device__ __forceinline__ void glds4s(const void*sbase,unsigned voff,unsigned lds_dst){unsigned keep;
  asm volatile("s_mov_b32 %0, m0\n\ts_mov_b32 m0, %3\n\ts_nop 0\n\tglobal_load_lds_dword %1, %2\n\ts_mov_b32 m0, %0":"=&s"(keep):"v"(voff),"s"(sbase),"s"(lds_dst):"memory");}
__device__ __forceinline__ float max3f(float a,float b,float c){float r;asm("v_max3_f32 %0, %1, %2, %3":"=v"(r):"v"(a),"v"(b),"v"(c));return r;}
__device__ __forceinline__ float max2f(float a,float b){float r;asm("v_max_f32_e32 %0, %1, %2":"=v"(r):"v"(a),"v"(b));return r;}
__device__ __forceinline__ float fadd_s(float a,float b){float r;asm("v_add_f32_e32 %0, %1, %2":"=v"(r):"v"(a),"v"(b));return r;}
__device__ __forceinline__ float fsub_s(float a,float b){float r;asm("v_sub_f32_e32 %0, %1, %2":"=v"(r):"v"(a),"v"(b));return r;}
typedef float f32x2_t __attribute__((ext_vector_type(2))); typedef __bf16 bf16x2_t __attribute__((ext_vector_type(2)));
__device__ __forceinline__ unsigned cvtpk_s(float lo,float hi){f32x2_t v={lo,hi};bf16x2_t b=__builtin_convertvector(v,bf16x2_t);return __builtin_bit_cast(unsigned,b);}
#define WAIT_BAR(N) asm volatile("s_waitcnt vmcnt(" #N ") lgkmcnt(0)\n\ts_barrier":::"memory")

__device__ __forceinline__ void qkt(f32x16&p0,f32x16&p1,const char*Kslot,const char*Cslot,const bf16x8*qr,const bf16x8 qx,int r32,int hi){
  const char*kb=Kslot+hi*1024+r32*16; const f32x16 zz=f32x16{};
  #pragma unroll
  for(int d0=0;d0<4;++d0){
    const bf16x8 b0=*reinterpret_cast<const bf16x8*>(kb+d0*2048);
    const bf16x8 b1=*reinterpret_cast<const bf16x8*>(kb+d0*2048+512);
    if(d0==0){p0=__builtin_amdgcn_mfma_f32_32x32x16_bf16(b0,qr[0],zz,0,0,0);p1=__builtin_amdgcn_mfma_f32_32x32x16_bf16(b1,qr[0],zz,0,0,0);}
    else{p0=__builtin_amdgcn_mfma_f32_32x32x16_bf16(b0,qr[d0],p0,0,0,0);p1=__builtin_amdgcn_mfma_f32_32x32x16_bf16(b1,qr[d0],p1,0,0,0);}}
  { const bf16x8 c0=*reinterpret_cast<const bf16x8*>(Cslot+r32*16), c1=*reinterpret_cast<const bf16x8*>(Cslot+512+r32*16);
    p0=__builtin_amdgcn_mfma_f32_32x32x16_bf16(c0,qx,p0,0,0,0);p1=__builtin_amdgcn_mfma_f32_32x32x16_bf16(c1,qx,p1,0,0,0); }
}
__device__ __forceinline__ unsigned bf_rne(float f){unsigned u=__builtin_bit_cast(unsigned,f);return (u+0x7fffu+((u>>16)&1u))>>16;}
__device__ __forceinline__ bf16x8 make_qx(float mhat,int hi){
  const float v=-mhat; const unsigned h=bf_rne(v); const float r1=v-__builtin_bit_cast(float,h<<16); const unsigned m=bf_rne(r1); const float r2=r1-__builtin_bit_cast(float,m<<16); const unsigned l=bf_rne(r2);
  u32x4 w; w.x=hi?0u:(0x3F80u|(0x3F80u<<16)); w.y=hi?0u:(0x3F80u|(h<<16)); w.z=hi?0u:(m|(l<<16)); w.w=0u; return __builtin_bit_cast(bf16x8,w);
}
typedef __attribute__((address_space(3))) const char* lds_cptr;
typedef short v4i16_t __attribute__((ext_vector_type(4)));
__device__ __forceinline__ void kload8(bf16x8*kf,lds_cptr kp){
  kf[0]=*(const __attribute__((address_space(3))) bf16x8*)(kp);      kf[1]=*(const __attribute__((address_space(3))) bf16x8*)(kp+512);
  kf[2]=*(const __attribute__((address_space(3))) bf16x8*)(kp+2048); kf[3]=*(const __attribute__((address_space(3))) bf16x8*)(kp+2560);
  kf[4]=*(const __attribute__((address_space(3))) bf16x8*)(kp+4096); kf[5]=*(const __attribute__((address_space(3))) bf16x8*)(kp+4608);
  kf[6]=*(const __attribute__((address_space(3))) bf16x8*)(kp+6144); kf[7]=*(const __attribute__((address_space(3))) bf16x8*)(kp+6656);
}
__device__ __forceinline__ void cload2(bf16x8*kc,lds_cptr cp){ kc[0]=*(const __attribute__((address_space(3))) bf16x8*)(cp); kc[1]=*(const __attribute__((address_space(3))) bf16x8*)(cp+512); }
__device__ __forceinline__ void kload2(bf16x8*kf,lds_cptr kp,int j){ kf[2*j]=*(const __attribute__((address_space(3))) bf16x8*)(kp+j*2048); kf[2*j+1]=*(const __attribute__((address_space(3))) bf16x8*)(kp+j*2048+512); }
__device__ __forceinline__ s16x4 vtr(lds_cptr p){ return __builtin_bit_cast(s16x4,__builtin_amdgcn_ds_read_tr16_b64_v4i16((__attribute__((address_space(3))) v4i16_t*)p)); }
__device__ __forceinline__ float rowmax(const f32x16&p0,const f32x16&p1){
  float a=max3f(p0[0],p0[1],p1[0]),b=max3f(p0[2],p0[3],p1[1]);a=max3f(a,p1[2],p1[3]);
  #pragma unroll
  for(int r=4;r<16;r+=4){a=max3f(a,p0[r],p0[r+1]);b=max3f(b,p0[r+2],p0[r+3]);a=max3f(a,p1[r],p1[r+1]);b=max3f(b,p1[r+2],p1[r+3]);}
  const float m=max2f(a,b);
  return max_x32(m);
}
__device__ __forceinline__ void pv(f32x16*o,int vb,bf16x8 pa0,bf16x8 pa1,bf16x8 pa2,bf16x8 pa3){
  #pragma unroll
  for(int d0=0;d0<2;++d0){s16x4 lo[4],hi[4];
    #pragma unroll
    for(int ks=0;ks<4;++ks){
      asm volatile("ds_read_b64_tr_b16 %0,%1 offset:%c2":"=&v"(lo[ks]):"v"(vb),"i"(d0*4096+ks*1024):"memory");
      asm volatile("ds_read_b64_tr_b16 %0,%1 offset:%c2":"=&v"(hi[ks]):"v"(vb),"i"(d0*4096+ks*1024+512):"memory");}
    asm volatile("s_waitcnt lgkmcnt(0)":::"memory");SBAR();
    #define PK(k) (bf16x8){lo[k][0],lo[k][1],lo[k][2],lo[k][3],hi[k][0],hi[k][1],hi[k][2],hi[k][3]}
    o[d0]=__builtin_amdgcn_mfma_f32_32x32x16_bf16(pa0,PK(0),o[d0],0,0,0);
    o[d0]=__builtin_amdgcn_mfma_f32_32x32x16_bf16(pa1,PK(1),o[d0],0,0,0);
    o[d0]=__builtin_amdgcn_mfma_f32_32x32x16_bf16(pa2,PK(2),o[d0],0,0,0);
    o[d0]=__builtin_amdgcn_mfma_f32_32x32x16_bf16(pa3,PK(3),o[d0],0,0,0);
    #undef PK
  }
}

#ifndef ATTN_STORE16
#define ATTN_STORE16(p,v) (*(u32x4*)(p)=(v))
#endif
template<int THRL> __device__ __forceinline__ void attn_unit(int wave_s,int b,int h,int qb,const bf16*Q,const bf16*__restrict__ K,const bf16*__restrict__ V,const bf16*__restrict__ KC,const bf16*__restrict__ GT,bf16*O,char*shm){
  const int lane=hw_lane(),r32=lane&31,hi=lane>>5; const int wid=wave_s;
  const long rowbase=(long)b*SEQ; const int q0=qb*QB;
  const bf16*Qw=Q+(rowbase+q0+wid*QBLK)*DM+h*D;
  const bf16*Kh=K+rowbase*DM+h*D,*Vh=V+rowbase*DM+h*D;
  const unsigned lds0=(unsigned)(uintptr_t)shm;
  float*wsf=(float*)(shm+LDS_WS)+wid*64;
  const unsigned koff=(unsigned)(lane*DM+wid*8)*2u;
  const unsigned voff=(unsigned)((16*(wid&3)+(lane>>2))*DM+(wid>>2)*32+(lane&3)*8)*2u;
  const unsigned kdst=lds0+LDS_K+wid*1024, vdst=lds0+LDS_V+wid*1024, cdst=lds0+LDS_C+wid*256;
  const char*cbase=(const char*)KC+((long)(b*NHEAD+h)*SEQ)*16; const unsigned coff=(unsigned)((wid&3)*256+lane*4);
  #define DMA_K(t,slot) do{ glds16s(Kh+(long)(t)*KVBLK*DM,koff,(unsigned)__builtin_amdgcn_readfirstlane(kdst+(slot))); glds4s(cbase+(long)(t)*1024,coff,(unsigned)__builtin_amdgcn_readfirstlane(cdst+((slot)>>2))); }while(0)
  #define DMA_V(t,slot) glds16s(Vh+(long)(t)*KVBLK*DM,voff,(unsigned)__builtin_amdgcn_readfirstlane(vdst+(slot)))
  const int vb0=(int)(lds0+LDS_V)+((lane>>4)&1)*32+(lane&3)*8+(4*hi+((lane&15)>>2))*64;
  const char*Kbase=shm+LDS_K; const char*Cbase=shm+LDS_C; bf16x8 kf[8]; bf16x8 kc[2];
  const lds_cptr shm3=(lds_cptr)shm; const lds_cptr kp0=shm3+LDS_K+hi*1024+r32*16; const lds_cptr cp0=shm3+LDS_C+r32*16; const lds_cptr vp0=shm3+LDS_V+((lane>>4)&1)*32+(lane&3)*8+(4*hi+((lane&15)>>2))*64;
  const int NT=(q0+QB)/KVBLK;
  DMA_K(0,0);DMA_V(0,0);DMA_K(1,SLOTB);
  bf16x8 qr[4];
  #pragma unroll
  for(int d0=0;d0<4;++d0)qr[d0]=*reinterpret_cast<const bf16x8*>(&Qw[(long)r32*DM+d0*16+hi*8]);
  float mhat=0.f,l_reg=0.f;f32x16 o[2];o[0]=f32x16{};o[1]=f32x16{};bf16x8 qx=make_qx(0.f,hi); const f32x16 zz=f32x16{};
  const int qrel=wid*QBLK+r32;
  #define CMASK(P0,P1,t) do{int jb_=(t)-(NT-4); if(jb_>=0)cmask(P0,P1,jb_,qrel,hi);}while(0)
  bool resc=false;
  #define START(P0,P1) do{ const float rm=rowmax(P0,P1); resc=false; \
    { const float dl=rm; mhat=fadd_s(mhat,dl); \
      _Pragma("unroll") for(int r=0;r<16;++r){P0[r]=fsub_s(P0[r],dl);P1[r]=fsub_s(P1[r],dl);} \
      qx=make_qx(mhat,hi); } \
    _Pragma("unroll") for(int r=0;r<16;++r)P0[r]=__builtin_amdgcn_exp2f(P0[r]); }while(0)
  #define RESC() do{ if(resc){ asm volatile("s_waitcnt lgkmcnt(0)":::"memory"); \
      _Pragma("unroll") for(int d_=0;d_<2;++d_) _Pragma("unroll") for(int r=0;r<16;++r)o[d_][r]*=wsf[crow(r,hi)]; } }while(0)
  f32x16 pA0,pA1,pB0,pB1;
  int sl_prev=0,sl_cur=0,sl_next=SLOTB;
  #define ROT() do{sl_prev=sl_cur;sl_cur=sl_next;sl_next=(sl_next==(NSLOT-1)*SLOTB)?0:sl_next+SLOTB;}while(0)
  DMA_K(2,2*SLOTB);
  WAIT_BAR(5);
  qkt(pA0,pA1,Kbase,Cbase,qr,qx,r32,hi);asm volatile("s_nop 15\n\ts_nop 7":"+v"(pA0),"+v"(pA1));CMASK(pA0,pA1,0);
  START(pA0,pA1);
  _Pragma("unroll") for(int r=0;r<16;++r)pA1[r]=__builtin_amdgcn_exp2f(pA1[r]);
  WAIT_BAR(0);
  DMA_K(3,0);DMA_V(1,SLOTB);
  ROT();
  kload8(kf,kp0+sl_cur); cload2(kc,cp0+(sl_cur>>2));
  WAIT_BAR(3);
  s16x4 vlo[8],vhi[8]; u32x4 pw0,pw1,pw2,pw3;
  #define PKW(P,B) cvtpk_s(P[B],P[B+1])
  #define PAF(k) __builtin_bit_cast(bf16x8,pw##k)
  #define VFR(i) (bf16x8){vlo[i][0],vlo[i][1],vlo[i][2],vlo[i][3],vhi[i][0],vhi[i][1],vhi[i][2],vhi[i][3]}
  #define PIN(x) asm volatile("":"+v"(x))
  #define MX3(a,b,c) __builtin_fmaxf(__builtin_fmaxf((a),(b)),(c))
  #define GAPA(MF,A0,A1,A2,A3,W0,W1,PW) do{ MF; sacc+=A0; sacc+=A1; sacc+=A2; sacc+=A3; PIN(sacc); W0; W1; PIN(PW); SBAR(); }while(0)
  #define EX(v) __builtin_amdgcn_exp2f(v)
  #define GAPB(MF,X,B) do{ MF; X[B]=EX(X[B]); X[B+1]=EX(X[B+1]); X[B+2]=EX(X[B+2]); X[B+3]=EX(X[B+3]); PIN(X); SBAR(); }while(0)
  #define VRD(i) do{ vlo[i]=vtr(vp_+(((i)>>2)*4096+((i)&3)*1024)); vhi[i]=vtr(vp_+(((i)>>2)*4096+((i)&3)*1024+512)); }while(0)
  #define KRD(G,j) do{ if(G){ kload2(kf,kp0+sl_next,j); SBAR(); } }while(0)
  #define STEP(C0,C1,P0,P1,t,GK,GV,GL) do{ SBAR(); \
    const lds_cptr vp_=vp0+sl_prev; \
    VRD(0); SBAR(); float sacc=(P0[0]+P0[1]); \
    C0=__builtin_amdgcn_mfma_f32_32x32x16_bf16(kc[0],qx,zz,0,0,0); C1=__builtin_amdgcn_mfma_f32_32x32x16_bf16(kc[1],qx,zz,0,0,0); SBAR(); \
    GAPA(C0=__builtin_amdgcn_mfma_f32_32x32x16_bf16(kf[0],qr[0],C0,0,0,0), P0[2],P0[3],P0[4],P0[5],     pw0[0]=PKW(P0,0), pw0[1]=PKW(P0,2), pw0); \
    VRD(4); SBAR(); GAPA(C1=__builtin_amdgcn_mfma_f32_32x32x16_bf16(kf[1],qr[0],C1,0,0,0), P0[6],P0[7],P0[8],P0[9],     pw0[2]=PKW(P0,4), pw0[3]=PKW(P0,6), pw0); \
    VRD(1); SBAR(); GAPA(C0=__builtin_amdgcn_mfma_f32_32x32x16_bf16(kf[2],qr[1],C0,0,0,0),   P0[10],P0[11],P0[12],P0[13], pw1[0]=PKW(P0,8), pw1[1]=PKW(P0,10), pw1); \
    VRD(5); SBAR(); GAPA(C1=__builtin_amdgcn_mfma_f32_32x32x16_bf16(kf[3],qr[1],C1,0,0,0),   P0[14],P0[15],P1[0],P1[1],   pw1[2]=PKW(P0,12),pw1[3]=PKW(P0,14), pw1); \
    VRD(2); SBAR(); GAPA(C0=__builtin_amdgcn_mfma_f32_32x32x16_bf16(kf[4],qr[2],C0,0,0,0),   P1[2],P1[3],P1[4],P1[5],     pw2[0]=PKW(P1,0), pw2[1]=PKW(P1,2), pw2); \
    VRD(6); SBAR(); GAPA(C1=__builtin_amdgcn_mfma_f32_32x32x16_bf16(kf[5],qr[2],C1,0,0,0),   P1[6],P1[7],P1[8],P1[9],     pw2[2]=PKW(P1,4), pw2[3]=PKW(P1,6), pw2); \
    VRD(3); SBAR(); GAPA(C0=__builtin_amdgcn_mfma_f32_32x32x16_bf16(kf[6],qr[3],C0,0,0,0),   P1[10],P1[11],P1[12],P1[13], pw3[0]=PKW(P1,8), pw3[1]=PKW(P1,10), pw3); \
    VRD(7); SBAR(); GAPA(C1=__builtin_amdgcn_mfma_f32_32x32x16_bf16(kf[7],qr[3],C1,0,0,0),   P1[14],P1[15],0.f,0.f,       pw3[2]=PKW(P1,12),pw3[3]=PKW(P1,14), pw3); \
    l_reg+=sacc; \
    if(GK){DMA_K((t)+3,sl_cur);} if(GV){DMA_V((t)+1,sl_next);} \
    CMASK(C0,C1,t); \
    { float a=MX3(C0[0],C0[1],C1[0]),b=MX3(C0[2],C0[3],C1[1]); a=MX3(a,C1[2],C1[3]); \
      _Pragma("unroll") for(int r=4;r<16;r+=4){a=MX3(a,C0[r],C0[r+1]);b=MX3(b,C0[r+2],C0[r+3]);a=MX3(a,C1[r],C1[r+1]);b=MX3(b,C1[r+2],C1[r+3]);} \
      float rm=__builtin_fmaxf(a,b); rm=max_x32(rm); \
      resc=false; \
      if(__builtin_expect(__any(rm>(float)THRL),0)){ const float dl=__builtin_fmaxf(rm,0.f); mhat+=dl; \
        _Pragma("unroll") for(int r=0;r<16;++r){C0[r]-=dl;C1[r]-=dl;} \
        qx=make_qx(mhat,hi); \
        const float f=__builtin_amdgcn_exp2f(-dl); l_reg*=f; if(hi==0)wsf[r32]=f; resc=true; } } \
    SBAR(); \
    GAPB(o[0]=__builtin_amdgcn_mfma_f32_32x32x16_bf16(PAF(0),VFR(0),o[0],0,0,0), C0,0); \
    GAPB(o[1]=__builtin_amdgcn_mfma_f32_32x32x16_bf16(PAF(0),VFR(4),o[1],0,0,0), C0,4); \
    KRD(GL,0); GAPB(o[0]=__builtin_amdgcn_mfma_f32_32x32x16_bf16(PAF(1),VFR(1),o[0],0,0,0), C0,8); \
    KRD(GL,1); GAPB(o[1]=__builtin_amdgcn_mfma_f32_32x32x16_bf16(PAF(1),VFR(5),o[1],0,0,0), C0,12); \
    KRD(GL,2); GAPB(o[0]=__builtin_amdgcn_mfma_f32_32x32x16_bf16(PAF(2),VFR(2),o[0],0,0,0), C1,0); \
    KRD(GL,3); if(GL){ cload2(kc,cp0+(sl_next>>2)); SBAR(); } GAPB(o[1]=__builtin_amdgcn_mfma_f32_32x32x16_bf16(PAF(2),VFR(6),o[1],0,0,0), C1,4); \
    GAPB(o[0]=__builtin_amdgcn_mfma_f32_32x32x16_bf16(PAF(3),VFR(3),o[0],0,0,0), C1,8); \
    GAPB(o[1]=__builtin_amdgcn_mfma_f32_32x32x16_bf16(PAF(3),VFR(7),o[1],0,0,0), C1,12); \
    }while(0)
  int t=1;
  #undef CMASK
  #define CMASK(P0,P1,t) do{}while(0)
  for(;t+5<NT;t+=2){
    STEP(pB0,pB1,pA0,pA1,t,true,true,true);     WAIT_BAR(3); RESC(); ROT();
    STEP(pA0,pA1,pB0,pB1,t+1,true,true,true);   WAIT_BAR(3); RESC(); ROT();
  }
  #undef CMASK
  #define CMASK(P0,P1,t) do{int jb_=(t)-(NT-4); if(jb_>=0)cmask(P0,P1,jb_,qrel,hi);}while(0)
  #define ENDW(tt) do{ if((tt)+3<NT){WAIT_BAR(3);} else if((tt)+2<NT){WAIT_BAR(1);} else {WAIT_BAR(0);} }while(0)
  for(;t+1<NT;t+=2){
    STEP(pB0,pB1,pA0,pA1,t,(t+3<NT),(t+1<NT),(t+1<NT));       ENDW(t);   RESC(); ROT();
    STEP(pA0,pA1,pB0,pB1,t+1,(t+4<NT),(t+2<NT),(t+2<NT));     ENDW(t+1); RESC(); ROT();
  }
  STEP(pB0,pB1,pA0,pA1,NT-1,false,false,false); RESC();
  { float sacc=pB0[0]+pB0[1]; _Pragma("unroll") for(int r=2;r<16;++r)sacc+=pB0[r]; _Pragma("unroll") for(int r=0;r<16;++r)sacc+=pB1[r]; l_reg+=sacc;
    pw0=(u32x4){PKW(pB0,0),PKW(pB0,2),PKW(pB0,4),PKW(pB0,6)};pw1=(u32x4){PKW(pB0,8),PKW(pB0,10),PKW(pB0,12),PKW(pB0,14)};pw2=(u32x4){PKW(pB1,0),PKW(pB1,2),PKW(pB1,4),PKW(pB1,6)};pw3=(u32x4){PKW(pB1,8),PKW(pB1,10),PKW(pB1,12),PKW(pB1,14)};
    SBAR(); pv(o,vb0+sl_cur,PAF(0),PAF(1),PAF(2),PAF(3)); }
  #undef PKW
  #undef PAF
  #undef VFR
  #undef PIN
  #undef MX3
  #undef GAPA
  #undef GAPB
  #undef EX
  #undef VRD
  #undef KRD
  #undef STEP
  #undef ENDW
  l_reg=add_x32(l_reg);
  if(hi==0)wsf[32+r32]=l_reg;asm volatile("s_waitcnt lgkmcnt(0)":::"memory");
  float rli[16];
  #pragma unroll
  for(int r=0;r<16;++r)rli[r]=__builtin_amdgcn_rcpf(wsf[32+crow(r,hi)]);
  bf16*Ow=O+(rowbase+q0+wid*QBLK)*DM+h*D;
  { bf16*stg=(bf16*)(shm+LDS_OST)+wid*2048;
    #pragma unroll
    for(int r=0;r<16;++r){const int orow=crow(r,hi);
      #pragma unroll
      for(int d0=0;d0<2;++d0)stg[orow*64+d0*32+r32]=__float2bfloat16(o[d0][r]*rli[r]);}
    asm volatile("s_waitcnt lgkmcnt(0)":::"memory");
    const bf16*Gw=GT+(rowbase+q0+wid*QBLK)*DM+h*D;
    #pragma unroll
    for(int i=0;i<4;++i){const int row=i*8+(lane>>3),ch=lane&7; const u32x4 v=*(const u32x4*)(stg+row*64+ch*8); const u32x4 g=*(const u32x4*)(Gw+(long)row*DM+ch*8); u32x4 w;
      #define GM(a,b) cvtpk_s(__builtin_bit_cast(float,(a)<<16)*__builtin_bit_cast(float,(b)<<16),__builtin_bit_cast(float,(a)&0xffff0000u)*__builtin_bit_cast(float,(b)&0xffff0000u))
      w.x=GM(v.x,g.x);w.y=GM(v.y,g.y);w.z=GM(v.z,g.z);w.w=GM(v.w,g.w);
      #undef GM
      ATTN_STORE16(Ow+(long)row*DM+ch*8,w);} }
  asm volatile("s_waitcnt lgkmcnt(0)\n\ts_barrier":::"memory");
  #undef DMA_K
  #undef DMA_V
  #undef CMASK
  #undef START
  #undef RESC
  #undef ROT
}
constexpr int ATTN_LDS_BYTES=LDS_BYTES;
struct AttnTensors { const bf16* Q; const bf16* K; const bf16* V; const bf16* KC; const bf16* G; bf16* O; };
struct AttnUnit { int bh; int qb; };
struct StaticOrder {
  int vcu, G;
  __device__ __forceinline__ explicit StaticOrder(int grid,int block):vcu((grid%8==0)?(block%8)*(grid/8)+block/8:block),G(grid){}
  __device__ __forceinline__ bool next(int i,AttnUnit&u)const{ if(G!=256){ const int L=i*G+vcu; if(L>=BATCH*NHEAD*NQB)return false; u.bh=L/NQB; u.qb=L%NQB; return true; } if(i>=8)return false; const int s=vcu&7,j=i&3; u.bh=(vcu>>3)+32*(i>>2); u.qb=(j==0)?s:(j==1)?15-s:(j==2)?16+s:31-s; return true; }
  __device__ __forceinline__ void a_ready(const AttnUnit&)const{}
  __device__ __forceinline__ void done(const AttnUnit&)const{}
};
template<class Sched,int THRL=8> __device__ __forceinline__ void attn_phase(char*lds,int wave_s,const AttnTensors&T,const Sched&S){
  AttnUnit u;
  for(int i=0;S.next(i,u);++i){ S.a_ready(u); attn_unit<THRL>(wave_s,u.bh/NHEAD,u.bh%NHEAD,u.qb,T.Q,T.K,T.V,T.KC,T.G,T.O,lds); S.done(u); }
}
#undef SBAR
#undef WAIT_BAR
}

constexpr int N_PHASES = 1 + DEPTH * 12;
#ifndef MK_MASK
#define MK_MASK 0xFFFFFFFFu
#endif
#define EN(n) ((((unsigned)(MK_MASK)) >> (n)) & 1u)

#define PH_PTRS CArgs* A = args_ptr(); unsigned char* ws = A->ws; (void)ws; const Ctx F = make_ctx(lds_raw, wave_s)
#define WSP(T, off) ((T*)(ws + (off)))
#define PJ(i) (WSP(bf16, WS_PROJ) + (size_t)(i) * M * DM)

#define PH_IN(k) (lo <= (k) && (k) < hi)
#if MK_PER_PHASE
#define PH_SEAM(k) do { } while (0)
#else
#define PH_SEAM(k) do { if ((k) + 1 < hi) xcd_barrier(bar); } while (0)
#endif
template <int L> __device__ __forceinline__ void layer_body(unsigned char* lds_raw, const int lo, const int hi, const int wave_s, const XcdBarrier& bar, LAS int* tab) {
    constexpr int kind = L % 3, pb = 1 + L * 12, j = L / 3;
        if (PH_IN(pb + 0)) {
            { PH_PTRS; const float* Hsrc = (L == 0) ? A->in[I_X] : WSP(float, WS_H);
              if (EN(18) && kind == 1) t1_fox(F, Hsrc, A->in[I_NORM_MIX] + L * DM, WSP(bf16, WS_XN), A->in[I_FOX_WIN], A->in[I_FOX_FB], WSP(float, WS_LSIG));
              else if (EN(1)) t1_plain(F, Hsrc, A->in[I_NORM_MIX] + L * DM, WSP(bf16, WS_XN)); }
            if (EN(19)) { PH_PTRS; pg8::StaticOrder S; S.init(WSP(bf16, WS_PB) + (size_t)L * M * PLED, WSP(bf16, WS_W_PLE) + (size_t)L * DM * PLED, M, DM, PLED, PLED, F.G, F.bid);
              pg8::EpiPleA E{WSP(bf16, WS_PW), WSP(float, WS_PSS)};
              pg8::gemm_phase<pg8::EpiPleA, pg8::StaticOrder, true>(F.lds, F.wave, pg8::GemmD{PLED, PLED}, S, E); }
            PH_SEAM(pb + 0);
        }
        if (kind == 0) {
            if (EN(2) && PH_IN(pb + 1)) { PH_PTRS;
                pg8::StaticOrder S; S.init(WSP(bf16, WS_XN), WSP(bf16, WS_W_HGIN) + (size_t)j * 4096 * DM, M, 4096, DM, DM, F.G, F.bid);
                pg8::EpiHgIn E{PJ(0), PJ(1), PJ(2), PJ(3), WSP(float, WS_F32A), WSP(float, WS_SMALL) + (L == 0 ? SM_LB0 / 4 : SM_LB3 / 4)};
                pg8::gemm_phase<pg8::EpiHgIn, pg8::StaticOrder, true>(F.lds, F.wave, pg8::GemmD{DM, DM}, S, E);
                PH_SEAM(pb + 1);
            }
            if (EN(3) && PH_IN(pb + 2)) { PH_PTRS; for (int u = F.vcu; u < 4096; u += F.G) hg_unit_a(F, u, WSP(float, WS_F32A), PJ(1), PJ(2), WSP(float, WS_HGG), WSP(float, WS_HGDEC)); PH_SEAM(pb + 2); }
            if (EN(4) && PH_IN(pb + 3)) { PH_PTRS; hg_scan_b(F, WSP(float, WS_HGG), WSP(float, WS_HGDEC), WSP(bf16, WS_HGS)); PH_SEAM(pb + 3); }
            if (EN(5) && PH_IN(pb + 4)) { PH_PTRS; for (int u = F.vcu; u < 4096; u += F.G) hg_unit_c(F, u, WSP(float, WS_F32A), PJ(0), PJ(1), PJ(2), PJ(3), WSP(bf16, WS_HGS), A->in[I_HG_GNORM] + j * 128, WSP(bf16, WS_MIXO)); PH_SEAM(pb + 4); }
        } else if (kind == 1) {
            if (EN(6) && PH_IN(pb + 1)) {
                { PH_PTRS; fox_cum(F, WSP(float, WS_LSIG), WSP(float, WS_FCUM), WSP(bf16, WS_KC)); }
                { PH_PTRS; pg8::StaticOrder S; S.init(WSP(bf16, WS_XN), WSP(bf16, WS_W_FOXIN), M, 4096, DM, DM, F.G, F.bid);
                  pg8::EpiFoxIn E{PJ(0), PJ(1), PJ(2), PJ(3), A->in[I_FOX_QN], A->in[I_FOX_KN], attn_body::C2};
                  pg8::gemm_phase<pg8::EpiFoxIn, pg8::StaticOrder, true>(F.lds, F.wave, pg8::GemmD{DM, DM}, S, E); }
                PH_SEAM(pb + 1);
            }
            if (EN(7) && PH_IN(pb + 2)) { PH_PTRS;
                const attn_body::AttnTensors AT{(const attn_body::bf16*)PJ(0), (const attn_body::bf16*)PJ(1), (const attn_body::bf16*)PJ(2), (const attn_body::bf16*)WSP(bf16, WS_KC), (const attn_body::bf16*)PJ(3), (attn_body::bf16*)WSP(bf16, WS_MIXO)};
                const attn_body::StaticOrder S((int)F.G, (int)F.bid);
                attn_body::attn_phase<attn_body::StaticOrder>((char*)lds_raw, F.wave, AT, S);
                PH_SEAM(pb + 2);
            }
        } else {
            if (EN(8) && PH_IN(pb + 1)) { PH_PTRS;
                pg8::StaticOrder S; S.init(WSP(bf16, WS_XN), WSP(bf16, WS_W_RGIN), M, 2048, DM, DM, F.G, F.bid);
                pg8::EpiRgIn E{PJ(0), PJ(1)};
                pg8::gemm_phase<pg8::EpiRgIn, pg8::StaticOrder, true>(F.lds, F.wave, pg8::GemmD{DM, DM}, S, E);
                PH_SEAM(pb + 1);
            }
            if (EN(9) && PH_IN(pb + 2)) { PH_PTRS; rg_conv(F, PJ(1), A->in[I_RG_CW], A->in[I_RG_CB], PJ(2)); PH_SEAM(pb + 2); }
            if (EN(10) && PH_IN(pb + 3)) { PH_PTRS;
                pg8::StaticOrder S; S.init(PJ(2), WSP(bf16, WS_W_RGAX), M, 2048, 256, DM, F.G, F.bid, 1);
                pg8::EpiRgGate E{PJ(2), A->in[I_RG_BA], A->in[I_RG_BX], WSP(float, WS_SMALL) + SM_SP8 / 4, WSP(float, WS_F32A), WSP(float, WS_F32B)};
                pg8::gemm_phase<pg8::EpiRgGate, pg8::StaticOrder, true>(F.lds, F.wave, pg8::GemmD{256, DM}, S, E);
                PH_SEAM(pb + 3);
            }
            if (EN(11) && PH_IN(pb + 4)) { PH_PTRS; rg_scan1(F, WSP(float, WS_F32A), WSP(float, WS_F32B), WSP(float, WS_SCAN)); PH_SEAM(pb + 4); }
            if (EN(11) && PH_IN(pb + 5)) { PH_PTRS; rg_scan2(F, WSP(float, WS_F32A), WSP(float, WS_F32B), WSP(float, WS_SCAN), PJ(0), WSP(bf16, WS_MIXO)); PH_SEAM(pb + 5); }
        }
        if (EN(12) && PH_IN(pb + 6)) { PH_PTRS;
            const bf16* Wo = kind == 0 ? WSP(bf16, WS_W_HGOUT) + (size_t)j * DM * DM : kind == 1 ? WSP(bf16, WS_W_FOXOUT) : WSP(bf16, WS_W_RGOUT);
            pg8::StaticOrder S; S.init(WSP(bf16, WS_MIXO), Wo, M, DM, DM, DM, F.G, F.bid);
            pg8::EpiResid E{(L == 0) ? A->in[I_X] : WSP(float, WS_H), WSP(float, WS_H)};
            pg8::gemm_phase<pg8::EpiResid, pg8::StaticOrder, true>(F.lds, F.wave, pg8::GemmD{DM, DM}, S, E);
            PH_SEAM(pb + 6);
        }
        if (EN(13) && PH_IN(pb + 7)) { PH_PTRS;
            t2_router(F, WSP(float, WS_H), A->in[I_NORM_FFN] + L * DM, WSP(bf16, WS_XN), A->in[I_RT_W] + (size_t)L * DM * NEXP, A->in[I_RT_B] + L * NEXP, (gu32*)(ws + WS_CTL) + CW_CNT + L * 32, WSP(unsigned, WS_LENT), WSP(float, WS_LGATE));
            PH_SEAM(pb + 7);
        }
        if (PH_IN(pb + 8) || PH_IN(pb + 9)) { PH_PTRS;
            __syncthreads();
            if (F.tid < 32) tab[40 + F.tid] = (int)__hip_atomic_load((gu32*)(ws + WS_CTL) + CW_CNT + L * 32 + F.tid, RLX_AGENT);
            __syncthreads();
            if (F.tid == 0) { int s = 0; for (int e = 0; e < 32; ++e) { tab[e] = s; s += (tab[40 + e] + 255) >> 8; } tab[32] = s; }
            __syncthreads();
        }
        if (EN(14) && PH_IN(pb + 8)) { PH_PTRS;
            pg8::MoeOrder<true, 3> S; S.tab = tab; S.G = F.G; S.vcu = F.vcu; S.total = __builtin_amdgcn_readfirstlane(tab[32]) << 3; S.A = (const char*)WSP(bf16, WS_XN); S.B = (const char*)(ws + WS_W_GU) + (size_t)L * 32 * 2048 * DM * 2;
            S.b_estride = (size_t)2048 * DM * 2; S.K = DM; S.lda = DM; S.lent = WSP(unsigned, WS_LENT);
            pg8::EpiMoeGU E{WSP(bf16, WS_ACT), A->in[I_GU_B] + (size_t)L * 32 * 2048};
            pg8::gemm_phase<pg8::EpiMoeGU, pg8::MoeOrder<true, 3>, true>(F.lds, F.wave, pg8::GemmD{DM, DM}, S, E);
            PH_SEAM(pb + 8);
        }
        if (EN(15) && PH_IN(pb + 9)) { PH_PTRS;
            pg8::MoeOrder<false, 2> S; S.tab = tab; S.G = F.G; S.vcu = F.vcu; S.total = __builtin_amdgcn_readfirstlane(tab[32]) << 2; S.A = (const char*)(ws + WS_ACT); S.B = (const char*)(ws + WS_W_DN) + (size_t)L * 32 * DM * DM * 2;
            S.b_estride = (size_t)DM * DM * 2; S.K = DM; S.lda = DM; S.lent = WSP(unsigned, WS_LENT);
            pg8::EpiMoeDN E{WSP(bf16, WS_Y), A->in[I_DN_B] + (size_t)L * 32 * DM, WSP(unsigned, WS_LENT), WSP(float, WS_LGATE), tab};
            pg8::gemm_phase<pg8::EpiMoeDN, pg8::MoeOrder<false, 2>, true>(F.lds, F.wave, pg8::GemmD{DM, DM}, S, E);
            PH_SEAM(pb + 9);
        }
        if (EN(16) && PH_IN(pb + 10)) { PH_PTRS; t3_combine(F, WSP(float, WS_H), WSP(bf16, WS_Y), A->in[I_PLE_GN] + L * DM, WSP(bf16, WS_GN), WSP(float, WS_PSS), WSP(float, WS_PRSTD)); PH_SEAM(pb + 10); }
        if (EN(17) && PH_IN(pb + 11)) { PH_PTRS;
            pg8::StaticOrder S; S.init(WSP(bf16, WS_GN), WSP(bf16, WS_W_PLEG) + (size_t)L * DM * DM, M, DM, DM, DM, F.G, F.bid);
            pg8::EpiPleFin E{WSP(float, WS_H), (L == DEPTH - 1) ? A->out : WSP(float, WS_H), WSP(bf16, WS_PW), WSP(float, WS_PRSTD), A->in[I_PLE_N] + L * DM};
            pg8::gemm_phase<pg8::EpiPleFin, pg8::StaticOrder, true>(F.lds, F.wave, pg8::GemmD{DM, DM}, S, E);
            PH_SEAM(pb + 11);
        }
}

__global__ void __launch_bounds__(NTHR, 2) mk_fwd(Args args) {
    extern __shared__ __attribute__((aligned(16))) unsigned char lds_raw[];
    volatile LAS unsigned* MISC = (volatile LAS unsigned*)((LAS unsigned char*)lds_raw + MISC_OFF);
    if (threadIdx.x < 32) MISC[threadIdx.x] = 0u;
    __syncthreads();
    XcdBarrier bar; bar.bar = (unsigned*)(args.ws + WS_CTL) + CW_BAR; bar.x = 0; bar.st = nullptr;
#if !MK_PER_PHASE
    bar = xcd_barrier_post((unsigned*)(args.ws + WS_CTL) + CW_BAR, MISC + 8);
#endif
    const int lo = args.lo, hi = args.hi;
    const int wave_s = __builtin_amdgcn_readfirstlane((int)threadIdx.x >> 6);
    LAS int* tab = (LAS int*)((LAS unsigned char*)lds_raw + LDSX_OFF + 8192);

    if (EN(0) && PH_IN(0)) { PH_PTRS; p0_prologue(F, A); PH_SEAM(0); }

    layer_body<0>(lds_raw, lo, hi, wave_s, bar, tab); layer_body<1>(lds_raw, lo, hi, wave_s, bar, tab); layer_body<2>(lds_raw, lo, hi, wave_s, bar, tab); layer_body<3>(lds_raw, lo, hi, wave_s, bar, tab);
#undef PH_IN
#undef PH_SEAM
}

extern "C" void kernel_launch(void* const* d_in, const int* in_sizes, int n_in, void* d_out, int out_size, void* d_ws, size_t ws_size, hipStream_t stream) {
    static int grid = 0;
    if (grid == 0) {
        if (n_in != N_IN || out_size != M * DM || ws_size < WS_END) { fprintf(stderr, "kernel_launch: unexpected shapes (n_in %d, out %d, ws %zu)\n", n_in, out_size, ws_size); grid = -1; return; }
        int dev = 0, cus = 0, per_cu = 0;
        if (hipGetDevice(&dev) != hipSuccess || hipDeviceGetAttribute(&cus, hipDeviceAttributeMultiprocessorCount, dev) != hipSuccess) { grid = -1; return; }
        if (hipFuncSetAttribute((const void*)mk_fwd, hipFuncAttributeMaxDynamicSharedMemorySize, LDS_BYTES) != hipSuccess) { fprintf(stderr, "kernel_launch: hipFuncSetAttribute failed\n"); grid = -1; return; }
        if (hipOccupancyMaxActiveBlocksPerMultiprocessor(&per_cu, (const void*)mk_fwd, NTHR, LDS_BYTES) != hipSuccess || per_cu < 1) { fprintf(stderr, "kernel_launch: occupancy query says %d blocks per CU\n", per_cu); }
        (void)hipGetLastError();
        grid = cus;
    }
    if (grid < 0) return;
    (void)hipMemsetAsync((char*)d_ws + WS_CTL, 0, CTL_ZERO_BYTES, stream);
    Args a{};
    for (int i = 0; i < N_IN; ++i) a.in[i] = (const float*)d_in[i];
    a.out = (float*)d_out; a.ws = (unsigned char*)d_ws;
#if MK_PER_PHASE
    for (int k = 0; k < N_PHASES; ++k) {
        if (k > 0) { const int L = (k - 1) / 12, p = (k - 1) % 12, kind = L % 3; if ((kind == 1 && (p == 3 || p == 4 || p == 5)) || (kind == 0 && p == 5)) continue; }
        a.lo = k; a.hi = k + 1;
        hipLaunchKernelGGL(mk_fwd, dim3(grid), dim3(NTHR), LDS_BYTES, stream, a);
#if defined(MK_DEBUG) && MK_DEBUG
        hipLaunchKernelGGL(mk_chk, dim3(64), dim3(256), 0, stream, a, k);
#endif
    }
#if defined(MK_DEBUG) && MK_DEBUG
    hipLaunchKernelGGL(mk_encode, dim3(1024), dim3(256), 0, stream, a, MK_DEBUG - 1);
#endif
#else
    a.lo = 0; a.hi = N_PHASES;
    hipLaunchKernelGGL(mk_fwd, dim3(grid), dim3(NTHR), LDS_BYTES, stream, a);
#endif
}
```

```cpp
#define MK_PER_PHASE 0
#include <hip/hip_runtime.h>
#include <cstdio>
#include <cstdint>
#include <hip/hip_bf16.h>
#include <cmath>

#ifndef MK_PER_PHASE
#define MK_PER_PHASE 0
#endif

#define GAS __attribute__((address_space(1)))
#define LAS __attribute__((address_space(3)))
typedef unsigned short bf16;
typedef unsigned short bf16_t;
typedef short bf16x8 __attribute__((ext_vector_type(8)));
typedef float f32x4 __attribute__((ext_vector_type(4)));
typedef float f32x2 __attribute__((ext_vector_type(2)));
typedef float f32x16 __attribute__((ext_vector_type(16)));
typedef unsigned u32x4 __attribute__((ext_vector_type(4)));
typedef unsigned u32x2 __attribute__((ext_vector_type(2)));
typedef GAS unsigned gu32;
#define RLX_AGENT __ATOMIC_RELAXED, __HIP_MEMORY_SCOPE_AGENT
#define LDS_WAIT() asm volatile("s_waitcnt lgkmcnt(0)" ::: "memory")
#define VM_WAIT() asm volatile("s_waitcnt vmcnt(0)" ::: "memory")

constexpr int NB = 4, SEQ = 8192, DM = 1024, M = NB * SEQ, DEPTH = 4;
constexpr int NEXP = 32, TOPK = 4, PLED = 256;
constexpr int FOXH = 16;
constexpr float EPS = 1e-6f;
constexpr int NWAVES = 8, NTHR = 512;

enum { I_X = 0, I_P, I_NORM_MIX, I_NORM_FFN, I_HG_WIN, I_HG_WOUT, I_HG_GNORM, I_HG_LB, I_FOX_WIN, I_FOX_FB, I_FOX_QN, I_FOX_KN, I_FOX_WOUT,
       I_RG_WIN, I_RG_CW, I_RG_CB, I_RG_WA, I_RG_BA, I_RG_WX, I_RG_BX, I_RG_LAM, I_RG_WOUT, I_RT_W, I_RT_B, I_GU_W, I_GU_B, I_DN_W, I_DN_B,
       I_PLE_W, I_PLE_N, I_PLE_GN, I_PLE_GW, N_IN };

struct Args { const float* in[N_IN]; float* out; unsigned char* ws; int lo, hi; };
typedef const __attribute__((address_space(4))) Args CArgs;
__device__ __forceinline__ CArgs* args_ptr() { CArgs* p = (CArgs*)__builtin_amdgcn_kernarg_segment_ptr(); asm volatile("" : "+s"(p)); return p; }

constexpr size_t MiB = 1u << 20;
constexpr size_t WS_CTL = 0, CTL_ZERO_BYTES = 1 * MiB;
constexpr size_t WS_SMALL = 1 * MiB;
constexpr size_t WS_W_HGIN = 8 * MiB;
constexpr size_t WS_W_HGOUT = 24 * MiB;
constexpr size_t WS_W_FOXIN = 28 * MiB;
constexpr size_t WS_W_FOXOUT = 36 * MiB;
constexpr size_t WS_W_RGIN = 38 * MiB;
constexpr size_t WS_W_RGAX = 42 * MiB;
constexpr size_t WS_W_RGOUT = 43 * MiB;
constexpr size_t WS_W_PLE = 45 * MiB;
constexpr size_t WS_W_PLEG = 47 * MiB;
constexpr size_t WS_W_GU = 64 * MiB;
constexpr size_t WS_W_DN = 576 * MiB;
constexpr size_t WS_PB = 832 * MiB;
constexpr size_t WS_H = 896 * MiB;
constexpr size_t WS_XN = 1024 * MiB;
constexpr size_t WS_PROJ = 1088 * MiB;
constexpr size_t WS_F32A = 1344 * MiB;
constexpr size_t WS_F32B = 1472 * MiB;
constexpr size_t WS_HGG = 1600 * MiB;
constexpr size_t WS_HGS = 1856 * MiB;
constexpr size_t WS_MIXO = 1984 * MiB;
constexpr size_t WS_ACT = 2048 * MiB;
constexpr size_t WS_Y = 2320 * MiB;
constexpr size_t WS_LENT = 2576 * MiB;
constexpr size_t WS_LGATE = 2580 * MiB;
constexpr size_t WS_PW = 2584 * MiB;
constexpr size_t WS_PSS = 2648 * MiB;
constexpr size_t WS_PRSTD = 2650 * MiB;
constexpr size_t WS_GN = 2652 * MiB;
constexpr size_t WS_LSIG = 2716 * MiB;
constexpr size_t WS_FCUM = 2718 * MiB;
constexpr size_t WS_KC = 2720 * MiB;
constexpr size_t WS_HGDEC = 2728 * MiB;
constexpr size_t WS_SCAN = 2730 * MiB;
constexpr size_t WS_END = 2736 * MiB;
constexpr size_t SM_LB0 = 0, SM_LB3 = 4096, SM_SP8 = 8192;

constexpr int CW_TMO = 0, CW_CODE = 1;
constexpr int CW_CNT = 1024;
constexpr int CW_BAR = 4096;

constexpr int RING_BYTES = 131072;
constexpr int LDSX_OFF = RING_BYTES;
constexpr int LDSX_BYTES = 24576;
constexpr int MISC_OFF = LDSX_OFF + LDSX_BYTES;
constexpr int LDS_BYTES = MISC_OFF + 128;

__device__ __forceinline__ int opaque_v(int x) { asm volatile("" : "+v"(x)); return x; }
__device__ __forceinline__ int hw_lane() { int l; asm volatile("v_mbcnt_lo_u32_b32 %0, -1, 0\n\tv_mbcnt_hi_u32_b32 %0, -1, %0" : "=v"(l)); return l; }
__device__ __forceinline__ unsigned f2bf(float f) { unsigned u = __builtin_bit_cast(unsigned, f); return (u + 0x7fffu + ((u >> 16) & 1u)) >> 16; }
__device__ __forceinline__ unsigned pk2(float lo, float hi) { return f2bf(lo) | (f2bf(hi) << 16); }
__device__ __forceinline__ float bf2f(unsigned short b) { return __builtin_bit_cast(float, (unsigned)b << 16); }
__device__ __forceinline__ float bflo(unsigned w) { return __builtin_bit_cast(float, w << 16); }
__device__ __forceinline__ float bfhi(unsigned w) { return __builtin_bit_cast(float, w & 0xffff0000u); }
__device__ __forceinline__ unsigned cvt_pk_bf16(float lo, float hi) { unsigned r; asm volatile("v_cvt_pk_bf16_f32 %0, %1, %2" : "=v"(r) : "v"(lo), "v"(hi)); return r; }
__device__ __forceinline__ float fexp(float x) { return __builtin_amdgcn_exp2f(x * 1.4426950408889634f); }
__device__ __forceinline__ float frcp(float x) { return __builtin_amdgcn_rcpf(x); }
__device__ __forceinline__ float sigmoidf_(float x) { return frcp(1.f + fexp(-x)); }
template <int MASK> __device__ __forceinline__ float sx(float v) { static_assert(MASK > 0 && MASK < 32, "sx: xor mask inside a 32-lane half"); return __builtin_bit_cast(float, __builtin_amdgcn_ds_swizzle(__builtin_bit_cast(int, v), (MASK << 10) | 0x1F)); }
__device__ __forceinline__ void swap32(float& a, float& b) { asm volatile("s_nop 1\n\tv_permlane32_swap_b32 %0, %1\n\ts_nop 1" : "+v"(a), "+v"(b)); }
__device__ __forceinline__ float add_x32(float v) { float a = v, b = v; swap32(a, b); return a + b; }
__device__ __forceinline__ float max_x32(float v) { float a = v, b = v; swap32(a, b); return fmaxf(a, b); }
__device__ __forceinline__ float wave_sum(float v) { v += sx<1>(v); v += sx<2>(v); v += sx<4>(v); v += sx<8>(v); v += sx<16>(v); return add_x32(v); }
__device__ __forceinline__ float wave_max(float v) { v = fmaxf(v, sx<1>(v)); v = fmaxf(v, sx<2>(v)); v = fmaxf(v, sx<4>(v)); v = fmaxf(v, sx<8>(v)); v = fmaxf(v, sx<16>(v)); return max_x32(v); }
#define XB_TMO      128
#define XB_XCNT(j)  (256  + 64 * (j))
#define XB_XSUB(j)  (1280 + 64 * (j))
#define XB_XGEN(j)  (2304 + 64 * (j))
#define XB_TOP      3328
#define XB_TOPGEN   3392
#define XCD_BAR_WORDS 3456
#define XB_SPIN_CAP (1u << 18)

__device__ __forceinline__ unsigned xb_ld(unsigned* p)              { return __hip_atomic_load(p, __ATOMIC_RELAXED, __HIP_MEMORY_SCOPE_AGENT); }
__device__ __forceinline__ unsigned xb_add(unsigned* p, unsigned v) { return __hip_atomic_fetch_add(p, v, __ATOMIC_RELAXED, __HIP_MEMORY_SCOPE_AGENT); }
__device__ __forceinline__ unsigned xb_xcc_id() { return (unsigned)__builtin_amdgcn_s_getreg((3 << 11) | 20) & 0xFu; }
#define XB_SPIN(cond, bar) do { unsigned _sp = 0; while (cond) { __builtin_amdgcn_s_sleep(1); \
    if ((++_sp & 255u) == 0u) { if (xb_ld(&(bar)[XB_TMO])) break; if (_sp > XB_SPIN_CAP) { atomicAdd(&(bar)[XB_TMO], 1u); break; } } } } while (0)

struct XcdBarrier {
    unsigned* bar; unsigned x;
    volatile LAS unsigned* st;
};

__device__ __forceinline__ XcdBarrier xcd_barrier_post(unsigned* bar, volatile LAS unsigned* st) {
    XcdBarrier b; b.bar = bar; b.x = xb_xcc_id(); b.st = st;
    if (threadIdx.x == 0) (void)xb_add(&bar[XB_XCNT(b.x)], 1u);
    return b;
}
__device__ __forceinline__ void xcd_barrier_complete(unsigned* bar, unsigned x, unsigned& nloc, unsigned& nx) {
    const unsigned G = gridDim.x * gridDim.y * gridDim.z;
    unsigned sum, cnt, mine, sp = 0u;
    for (;;) {
        sum = 0u; cnt = 0u; mine = 0u;
#pragma unroll
        for (unsigned j = 0; j < 16; ++j) { const unsigned c = xb_ld(&bar[XB_XCNT(j)]); sum += c; cnt += (c > 0u) ? 1u : 0u; mine = (j == x) ? c : mine; }
        if (sum == G) break;
        __builtin_amdgcn_s_sleep(1);
        if ((++sp & 255u) == 0u) { if (xb_ld(&bar[XB_TMO])) break; if (sp > XB_SPIN_CAP) { atomicAdd(&bar[XB_TMO], 1u); break; } }
    }
    nloc = mine > 0u ? mine : 1u; nx = cnt > 0u ? cnt : 1u;
}

__device__ __forceinline__ void xcd_barrier(const XcdBarrier& b) {
    asm volatile("s_waitcnt vmcnt(0)" ::: "memory");
    __syncthreads();
    if (threadIdx.x == 0) {
        unsigned* bar = b.bar;
        __builtin_amdgcn_s_waitcnt(0);
        unsigned nloc = b.st[0], nx = b.st[1];
        if (nloc == 0u) { xcd_barrier_complete(bar, b.x, nloc, nx); b.st[0] = nloc; b.st[1] = nx; }
        const unsigned old = xb_add(&bar[XB_XSUB(b.x)], 1u);
        const unsigned gen = old / nloc;
        if (old + 1u == (gen + 1u) * nloc) {
            __builtin_amdgcn_fence(__ATOMIC_RELEASE, "agent");
            asm volatile("s_waitcnt vmcnt(0)" ::: "memory");
            const unsigned og = xb_add(&bar[XB_TOP], 1u);
            const unsigned tg = og / nx;
            if (og + 1u == (tg + 1u) * nx) xb_add(&bar[XB_TOPGEN], 1u);
            else XB_SPIN(xb_ld(&bar[XB_TOPGEN]) == tg, bar);
            __builtin_amdgcn_fence(__ATOMIC_ACQUIRE, "agent");
            xb_add(&bar[XB_XGEN(b.x)], 1u);
            asm volatile("s_waitcnt vmcnt(0)" ::: "memory");
        } else {
            XB_SPIN(xb_ld(&bar[XB_XGEN(b.x)]) == gen, bar);
            __builtin_amdgcn_fence(__ATOMIC_ACQUIRE, "agent");
            asm volatile("s_waitcnt vmcnt(0)" ::: "memory");
        }
    }
    __syncthreads();
}

namespace pg8 {
constexpr int BM = 256, BK = 64, HALF = 128, HTB = HALF * BK * 2  , NXCD = 8, WGM = 8;
__host__ __device__ __forceinline__ int lds_byte(int r, int c) { const int st = (r >> 4) * 2 + (c >> 5), rr = r & 15, cc = c & 31, ob = rr * 64 + cc * 2; return st * 1024 + (ob ^ (((ob >> 9) & 1) << 5)); }
__host__ __device__ __forceinline__ void stage_rc(int b, int& R, int& C) { const int st = b / 1024, sb = b % 1024, swz = sb ^ (((sb >> 9) & 1) << 5); R = (st >> 1) * 16 + swz / 64; C = (st & 1) * 32 + (swz % 64) / 2; }
__host__ __device__ __forceinline__ int perm32(int rho) { const int n = rho >> 4, i = rho & 15; return 8 * (i >> 2) + 4 * n + (i & 3); }

__device__ __forceinline__ void glds16s(const void* sbase, unsigned voff, unsigned lds_dst) { unsigned keep;
    asm volatile("s_mov_b32 %0, m0\n\ts_mov_b32 m0, %3\n\ts_nop 0\n\tglobal_load_lds_dwordx4 %1, %2\n\ts_mov_b32 m0, %0" : "=&s"(keep) : "v"(voff), "s"(sbase), "s"(lds_dst) : "memory"); }
struct Unit { int pm, pn, e, nv; };
struct GemmD { int K, lda; };

struct StaticOrder {
    int nM, nN, nwg, G, c; const char* A; const char* B; int K, lda; int a_pn_shift;
    static constexpr bool GATHER = false;
    __device__ void init(const void* A_, const void* B_, int Mrows, int N, int K_, int lda_, int G_, int c_, int aps = -1) { A = (const char*)A_; B = (const char*)B_; nM = Mrows / BM; nN = N / BM; nwg = nM * nN; G = G_; c = c_; K = K_; lda = lda_; a_pn_shift = aps; }
    __device__ __forceinline__ bool next(int i, Unit& u) const {
        const long L = (long)i * G + c; if (L >= nwg) return false;
        int wgid = (int)L; { const int q = nwg / NXCD, r = nwg % NXCD, xcd = wgid % NXCD, off = wgid / NXCD; wgid = (xcd < r ? xcd * (q + 1) : r * (q + 1) + (xcd - r) * q) + off; }
        const int nig = WGM * nN, gid = wgid / nig, fm = gid * WGM, gsz = (nM - fm) < WGM ? (nM - fm) : WGM;
        u.pm = fm + ((wgid % nig) % gsz); u.pn = (wgid % nig) / gsz; u.e = 0; u.nv = 256; return true;
    }
    __device__ __forceinline__ const char* a_ptr(const Unit& u) const { return A + ((size_t)u.pm * BM * lda + (a_pn_shift >= 0 ? (size_t)(u.pn >> a_pn_shift) * K : 0)) * 2; }
    __device__ __forceinline__ const char* b_ptr(const Unit& u) const { return B + (size_t)u.pn * BM * K * 2; }
    __device__ __forceinline__ void gather(const Unit&, int, int, int (&rows)[4]) const { rows[0] = rows[1] = rows[2] = rows[3] = 0; }
};

template <class Epi, class Sched, bool ALIGN_EPI>
__device__ __forceinline__ void gemm_phase(LAS unsigned char* lds, int wid, const GemmD g, const Sched& S, const Epi& E) {
    const int lane = hw_lane(), tid = wid * 64 + lane, wr = wid >> 2, wc = wid & 3, fr = lane & 15, fq = lane >> 4;
    const int K = g.K, nt = K / BK, lda = g.lda;
    int R[2], C[2]; unsigned voffB[2];
#pragma unroll
    for (int i = 0; i < 2; ++i) { stage_rc(tid * 16 + i * 8192, R[i], C[i]); const int Rb = (R[i] & ~31) + perm32(R[i] & 31); voffB[i] = (unsigned)(Rb * K + C[i]) * 2u; }
    const size_t kstep = (size_t)(BK * 2);
    const size_t hstepB = (size_t)HALF * K * 2;
    const size_t hstepA = Sched::GATHER ? 0 : (size_t)HALF * lda * 2;
    const unsigned lds0 = (unsigned)(uintptr_t)lds + (unsigned)wid * 1024u;
    const int aoff = lds_byte(wr * 64 + fr, fq * 8), boff = lds_byte(wc * 32 + fr, fq * 8);
#define PG8_SA(b, h) (((b) * 2 + (h)) * HTB)
#define PG8_SB(b, h) ((4 + (b) * 2 + (h)) * HTB)
#define PG8_STAGEB(bufoff, gbase) do { glds16s((gbase), voffB[0], lds0 + (bufoff)); glds16s((gbase), voffB[1], lds0 + (bufoff) + 8192); } while (0)
#define PG8_STAGEA(bufoff, gbase, v0, v1) do { glds16s((gbase), (v0), lds0 + (bufoff)); glds16s((gbase), (v1), lds0 + (bufoff) + 8192); } while (0)
#define PG8_LDA(dst, b, h) do { _Pragma("unroll") for (int m = 0; m < 4; ++m) _Pragma("unroll") for (int k = 0; k < 2; ++k) dst[m][k] = *(const LAS bf16x8*)(lds + PG8_SA(b, h) + aoff + m * 2048 + k * 1024); } while (0)
#define PG8_LDB(dst, b, h) do { _Pragma("unroll") for (int n = 0; n < 2; ++n) _Pragma("unroll") for (int k = 0; k < 2; ++k) dst[n][k] = *(const LAS bf16x8*)(lds + PG8_SB(b, h) + boff + n * 2048 + k * 1024); } while (0)
#define PG8_MMA(ai, bj, At, Bt) do { __builtin_amdgcn_s_setprio(1); _Pragma("unroll") for (int m = 0; m < 4; ++m) _Pragma("unroll") for (int n = 0; n < 2; ++n) _Pragma("unroll") for (int k = 0; k < 2; ++k) \
        acc[ai][bj][m][n] = __builtin_amdgcn_mfma_f32_16x16x32_bf16(Bt[n][k], At[m][k], acc[ai][bj][m][n], 0, 0, 0); __builtin_amdgcn_s_setprio(0); } while (0)
#define PG8_WAIT_V(n) asm volatile("s_waitcnt vmcnt(" #n ")" ::: "memory")
#define PG8_WAIT_L(n) asm volatile("s_waitcnt lgkmcnt(" #n ")" ::: "memory")
#define PG8_BAR __builtin_amdgcn_s_barrier()
#define PG8_SCHED __builtin_amdgcn_sched_barrier(0)
#define PG8_OFFS(dst, rows) do { if constexpr (Sched::GATHER) { dst[0] = (unsigned)(rows[0] * lda + C[0]) * 2u; dst[1] = (unsigned)(rows[1] * lda + C[1]) * 2u; dst[2] = (unsigned)(rows[2] * lda + C[0]) * 2u; dst[3] = (unsigned)(rows[3] * lda + C[1]) * 2u; } } while (0)
    Unit cur, nxt, nn; int ui = 0;
    if (!S.next(0, cur)) return;
    bool has_next = S.next(1, nxt);
    unsigned vAc[4], vAn[4];
    if constexpr (Sched::GATHER) {
        int r0[4], r1[4]; S.gather(cur, R[0], R[1], r0); if (has_next) S.gather(nxt, R[0], R[1], r1); else { r1[0] = r0[0]; r1[1] = r0[1]; r1[2] = r0[2]; r1[3] = r0[3]; }
        PG8_OFFS(vAc, r0); PG8_OFFS(vAn, r1);
    } else {
#pragma unroll
        for (int h = 0; h < 2; ++h)
#pragma unroll
            for (int i = 0; i < 2; ++i) { vAc[h * 2 + i] = (unsigned)(R[i] * lda + C[i]) * 2u; vAn[h * 2 + i] = vAc[h * 2 + i]; }
    }
    f32x4 acc[2][2][4][2];
#pragma unroll
    for (int a = 0; a < 2; ++a)
#pragma unroll
        for (int b = 0; b < 2; ++b)
#pragma unroll
            for (int m = 0; m < 4; ++m)
#pragma unroll
                for (int n = 0; n < 2; ++n) acc[a][b][m][n] = (f32x4){0.f, 0.f, 0.f, 0.f};
    bf16x8 At[4][2], B0[2][2], B1[2][2];
    const char* cA = S.a_ptr(cur); const char* cB = S.b_ptr(cur);
    PG8_STAGEB(PG8_SB(0, 0), cB); PG8_STAGEB(PG8_SB(0, 1), cB + hstepB); PG8_STAGEA(PG8_SA(0, 0), cA, vAc[0], vAc[1]); PG8_STAGEA(PG8_SA(0, 1), cA + hstepA, vAc[2], vAc[3]);
    if (wr == 1) PG8_BAR;
    PG8_WAIT_V(2); PG8_BAR;
    PG8_STAGEB(PG8_SB(1, 0), cB + kstep); PG8_STAGEA(PG8_SA(1, 0), cA + kstep, vAc[0], vAc[1]); PG8_STAGEB(PG8_SB(1, 1), cB + hstepB + kstep);
    PG8_WAIT_V(6); PG8_BAR;
    for (;;) {
        const char* nA = has_next ? S.a_ptr(nxt) : cA; const char* nB = has_next ? S.b_ptr(nxt) : cB;
        for (int t = 0; t < nt; t += 2) {
            const bool last = (t == nt - 2);
            const char* a1 = cA + (size_t)(t + 1) * kstep;
            const char* a2 = last ? nA : cA + (size_t)(t + 2) * kstep; const char* b2 = last ? nB : cB + (size_t)(t + 2) * kstep;
            const char* a3 = a2 + kstep; const char* b3 = b2 + kstep;
            unsigned x0 = vAc[0], x1 = vAc[1], x2 = vAc[2], x3 = vAc[3];
            if constexpr (Sched::GATHER) { if (last) { x0 = vAn[0]; x1 = vAn[1]; x2 = vAn[2]; x3 = vAn[3]; } }
            PG8_LDB(B0, 0, 0); PG8_LDB(B1, 0, 1); PG8_SCHED; PG8_LDA(At, 0, 0); PG8_STAGEA(PG8_SA(1, 1), a1 + hstepA, vAc[2], vAc[3]);
            PG8_WAIT_V(8); PG8_WAIT_L(0); PG8_BAR; PG8_MMA(0, 0, At, B0); PG8_MMA(0, 1, At, B1); PG8_BAR; PG8_SCHED;
            PG8_LDA(At, 0, 1); PG8_STAGEB(PG8_SB(0, 0), b2); PG8_STAGEB(PG8_SB(0, 1), b2 + hstepB); PG8_STAGEA(PG8_SA(0, 0), a2, x0, x1);
            PG8_WAIT_V(8); PG8_WAIT_L(0); PG8_BAR; PG8_MMA(1, 0, At, B0); PG8_MMA(1, 1, At, B1); PG8_BAR; PG8_SCHED;
            PG8_LDB(B0, 1, 0); PG8_LDB(B1, 1, 1); PG8_SCHED; PG8_LDA(At, 1, 0); PG8_STAGEA(PG8_SA(0, 1), a2 + hstepA, x2, x3);
            PG8_WAIT_V(8); PG8_WAIT_L(0); PG8_BAR; PG8_MMA(0, 0, At, B0); PG8_MMA(0, 1, At, B1); PG8_BAR; PG8_SCHED;
            PG8_LDA(At, 1, 1); PG8_STAGEB(PG8_SB(1, 0), b3); PG8_STAGEB(PG8_SB(1, 1), b3 + hstepB); PG8_STAGEA(PG8_SA(1, 0), a3, x0, x1);
            PG8_WAIT_V(8); PG8_WAIT_L(0); PG8_BAR; PG8_MMA(1, 0, At, B0); PG8_MMA(1, 1, At, B1); PG8_BAR; PG8_SCHED;
        }
        bool has_nn = false; int rn[4] = {0, 0, 0, 0};
        if (has_next) { has_nn = S.next(ui + 2, nn); if constexpr (Sched::GATHER) { if (has_nn) S.gather(nn, R[0], R[1], rn); } }
        if constexpr (ALIGN_EPI) { if (wr == 0) PG8_BAR; }
        E(acc, cur, wr, wc, fr, fq);
        if (!has_next) break;
#pragma unroll
        for (int a = 0; a < 2; ++a)
#pragma unroll
            for (int b = 0; b < 2; ++b)
#pragma unroll
                for (int m = 0; m < 4; ++m)
#pragma unroll
                    for (int n = 0; n < 2; ++n) acc[a][b][m][n] = (f32x4){0.f, 0.f, 0.f, 0.f};
        cur = nxt; cA = nA; cB = nB; ++ui;
        if constexpr (Sched::GATHER) { vAc[0] = vAn[0]; vAc[1] = vAn[1]; vAc[2] = vAn[2]; vAc[3] = vAn[3]; if (has_nn) PG8_OFFS(vAn, rn); }
        nxt = nn; has_next = has_nn;
        if constexpr (ALIGN_EPI) { if (wr == 1) PG8_BAR; }
    }
    PG8_WAIT_V(0);
    if constexpr (!ALIGN_EPI) { if (wr == 0) PG8_BAR; }
    PG8_BAR;
#undef PG8_SA
#undef PG8_SB
#undef PG8_STAGEA
#undef PG8_STAGEB
#undef PG8_LDA
#undef PG8_LDB
#undef PG8_MMA
#undef PG8_WAIT_V
#undef PG8_WAIT_L
#undef PG8_BAR
#undef PG8_SCHED
#undef PG8_OFFS
}
}

namespace pg8 {
template <bool GATHER_, int CSH>
struct MoeOrder {
    static constexpr bool GATHER = GATHER_;
    const LAS int* tab; int G, vcu, total; const char* A; const char* B; size_t b_estride; int K, lda; const unsigned* lent;
    __device__ __forceinline__ bool next(int i, Unit& u) const {
        const int L = i * G + vcu; if (L >= total) return false;
        const int tile = L >> CSH; int e = 0;
        while (tab[e + 1] <= tile) ++e;
        e = __builtin_amdgcn_readfirstlane(e);
        const int rt = tile - __builtin_amdgcn_readfirstlane(tab[e]); const int rem = __builtin_amdgcn_readfirstlane(tab[40 + e]) - rt * 256;
        u.pm = tile; u.pn = L & ((1 << CSH) - 1); u.e = e; u.nv = rem < 256 ? rem : 256; return true;
    }
    __device__ __forceinline__ int lbase(const Unit& u) const { return u.e * 32768 + (u.pm - __builtin_amdgcn_readfirstlane(tab[u.e])) * 256; }
    __device__ __forceinline__ const char* a_ptr(const Unit& u) const { return GATHER ? A : A + (size_t)u.pm * 256 * lda * 2; }
    __device__ __forceinline__ const char* b_ptr(const Unit& u) const { return B + (size_t)u.e * b_estride + (size_t)u.pn * 256 * K * 2; }
    __device__ __forceinline__ void gather(const Unit& u, int R0, int R1, int (&rows)[4]) const {
        const unsigned* l = lent + lbase(u);
        const int i0 = R0, i1 = R1, i2 = 128 + R0, i3 = 128 + R1;
        rows[0] = i0 < u.nv ? (int)(l[i0] >> 2) : 0; rows[1] = i1 < u.nv ? (int)(l[i1] >> 2) : 0;
        rows[2] = i2 < u.nv ? (int)(l[i2] >> 2) : 0; rows[3] = i3 < u.nv ? (int)(l[i3] >> 2) : 0;
    }
};

#define EPI_ARGS const f32x4 (&acc)[2][2][4][2], const Unit& u, int wr, int wc, int fr, int fq
__device__ __forceinline__ void st_bf8(bf16* p, f32x4 v0, f32x4 v1) { u32x4 w; w.x = cvt_pk_bf16(v0[0], v0[1]); w.y = cvt_pk_bf16(v0[2], v0[3]); w.z = cvt_pk_bf16(v1[0], v1[1]); w.w = cvt_pk_bf16(v1[2], v1[3]); *(u32x4*)p = w; }
__device__ __forceinline__ float silu_(float x) { return x * frcp(1.f + fexp(-x)); }

struct EpiHgIn {
    bf16 *Q, *Kk, *V, *G; float* LF; const float* lb;
    __device__ __forceinline__ void operator()(EPI_ARGS) const {
        const int sec = u.pn >> 2, row0 = u.pm * 256 + wr * 64 + fr, col0 = (u.pn & 3) * 256 + wc * 32 + 8 * fq;
        f32x4 lbv[2][2];
#pragma unroll
        for (int bj = 0; bj < 2; ++bj) { lbv[bj][0] = *(const f32x4*)(lb + col0 + bj * 128); lbv[bj][1] = *(const f32x4*)(lb + col0 + bj * 128 + 4); }
#pragma unroll
        for (int ai = 0; ai < 2; ++ai)
#pragma unroll
            for (int m = 0; m < 4; ++m) { const size_t ro = (size_t)(row0 + ai * 128 + m * 16) * DM;
#pragma unroll
                for (int bj = 0; bj < 2; ++bj) { const int col = col0 + bj * 128; f32x4 v0 = acc[ai][bj][m][0], v1 = acc[ai][bj][m][1];
                    if (sec == 0) {
#pragma unroll
                        for (int j = 0; j < 4; ++j) { v0[j] = silu_(v0[j]) * 0.08838834764831845f; v1[j] = silu_(v1[j]) * 0.08838834764831845f; }
                        st_bf8(Q + ro + col, v0, v1);
                    } else if (sec == 1) {
                        f32x4 l0, l1, k0, k1;
#pragma unroll
                        for (int j = 0; j < 4; ++j) {
                            { const float z = fmaxf(v0[j], -80.f), e = fexp(-z), s = frcp(1.f + e), lbb = lbv[bj][0][j]; l0[j] = __logf(lbb + (1.f - lbb) * s); k0[j] = (1.f - lbb) * e * s; }
                            { const float z = fmaxf(v1[j], -80.f), e = fexp(-z), s = frcp(1.f + e), lbb = lbv[bj][1][j]; l1[j] = __logf(lbb + (1.f - lbb) * s); k1[j] = (1.f - lbb) * e * s; }
                        }
                        *(f32x4*)(LF + ro + col) = l0; *(f32x4*)(LF + ro + col + 4) = l1;
                        st_bf8(Kk + ro + col, k0, k1);
                    } else if (sec == 2) { st_bf8(V + ro + col, v0, v1);
                    } else {
#pragma unroll
                        for (int j = 0; j < 4; ++j) { v0[j] = silu_(v0[j]); v1[j] = silu_(v1[j]); }
                        st_bf8(G + ro + col, v0, v1);
                    } } __builtin_amdgcn_sched_barrier(0); }
    }
};

struct EpiResid {
    const float* src; float* dst;
    __device__ __forceinline__ void operator()(EPI_ARGS) const {
        const int row0 = u.pm * 256 + wr * 64 + fr, col0 = u.pn * 256 + wc * 32 + 8 * fq;
#pragma unroll
        for (int ai = 0; ai < 2; ++ai)
#pragma unroll
            for (int m = 0; m < 4; ++m) { const size_t ro = (size_t)(row0 + ai * 128 + m * 16) * DM;
#pragma unroll
                for (int bj = 0; bj < 2; ++bj) { const size_t o = ro + col0 + bj * 128;
                    const f32x4 a = *(const f32x4*)(src + o), b = *(const f32x4*)(src + o + 4);
                    *(f32x4*)(dst + o) = a + acc[ai][bj][m][0]; *(f32x4*)(dst + o + 4) = b + acc[ai][bj][m][1]; } }
    }
};

struct EpiFoxIn {
    bf16 *Q, *Kk, *V, *G; const float *qn, *kn; float qscale;
    __device__ __forceinline__ void operator()(EPI_ARGS) const {
        const int sec = u.pn >> 2, pnl = u.pn & 3, row0 = u.pm * 256 + wr * 64 + fr;
        if (sec < 2) {
            const float* gn = sec == 0 ? qn : kn; const float sc = sec == 0 ? qscale : 1.f; bf16* O = sec == 0 ? Q : Kk;
            f32x4 g[2][2];
#pragma unroll
            for (int bj = 0; bj < 2; ++bj) { g[bj][0] = *(const f32x4*)(gn + bj * 32 + 8 * fq) * sc; g[bj][1] = *(const f32x4*)(gn + bj * 32 + 8 * fq + 4) * sc; }
            const int colh = (pnl * 4 + wc) * 64 + 8 * fq;
#pragma unroll
            for (int ai = 0; ai < 2; ++ai)
#pragma unroll
                for (int m = 0; m < 4; ++m) { const size_t ro = (size_t)(row0 + ai * 128 + m * 16) * DM;
                    float ss = 0.f;
#pragma unroll
                    for (int bj = 0; bj < 2; ++bj)
#pragma unroll
                        for (int n = 0; n < 2; ++n) { const f32x4 x = acc[ai][bj][m][n]; ss += (x[0] * x[0] + x[1] * x[1]) + (x[2] * x[2] + x[3] * x[3]); }
                    ss += sx<16>(ss); ss = add_x32(ss);
                    const float rstd = __builtin_amdgcn_rsqf(ss * (1.f / 64.f) + EPS);
#pragma unroll
                    for (int bj = 0; bj < 2; ++bj) st_bf8(O + ro + colh + bj * 32, acc[ai][bj][m][0] * rstd * g[bj][0], acc[ai][bj][m][1] * rstd * g[bj][1]); __builtin_amdgcn_sched_barrier(0); }
        } else {
            const int col0 = pnl * 256 + wc * 32 + 8 * fq;
#pragma unroll
            for (int ai = 0; ai < 2; ++ai)
#pragma unroll
                for (int m = 0; m < 4; ++m) { const size_t ro = (size_t)(row0 + ai * 128 + m * 16) * DM;
#pragma unroll
                    for (int bj = 0; bj < 2; ++bj) { f32x4 v0 = acc[ai][bj][m][0], v1 = acc[ai][bj][m][1];
                        if (sec == 3) {
#pragma unroll
                            for (int j = 0; j < 4; ++j) { v0[j] = sigmoidf_(v0[j]); v1[j] = sigmoidf_(v1[j]); } }
                        st_bf8((sec == 2 ? V : G) + ro + col0 + bj * 128, v0, v1); } __builtin_amdgcn_sched_barrier(0); }
        }
    }
};

__device__ __forceinline__ float gelu_tanh_(float x) { const float t = 1.5957691216057308f * (x + 0.044715f * x * x * x); return x * frcp(1.f + fexp(-t)); }
struct EpiRgIn {
    bf16 *GATE, *U;
    __device__ __forceinline__ void operator()(EPI_ARGS) const {
        const int sec = u.pn >> 2, row0 = u.pm * 256 + wr * 64 + fr, col0 = (u.pn & 3) * 256 + wc * 32 + 8 * fq;
#pragma unroll
        for (int ai = 0; ai < 2; ++ai)
#pragma unroll
            for (int m = 0; m < 4; ++m) { const size_t ro = (size_t)(row0 + ai * 128 + m * 16) * DM;
#pragma unroll
                for (int bj = 0; bj < 2; ++bj) { f32x4 v0 = acc[ai][bj][m][0], v1 = acc[ai][bj][m][1];
                    if (sec == 0) {
#pragma unroll
                        for (int j = 0; j < 4; ++j) { v0[j] = gelu_tanh_(v0[j]); v1[j] = gelu_tanh_(v1[j]); } }
                    st_bf8((sec == 0 ? GATE : U) + ro + col0 + bj * 128, v0, v1); } __builtin_amdgcn_sched_barrier(0); }
    }
};

struct EpiRgGate {
    const bf16* UC; const float *ba, *bx, *sp8; float *A, *X;
    __device__ __forceinline__ void operator()(EPI_ARGS) const {
        const int row0 = u.pm * 256 + wr * 64 + fr, c0 = u.pn * 128 + wc * 32 + 8 * fq;
#pragma unroll
        for (int n = 0; n < 2; ++n) {
            const f32x4 bav = *(const f32x4*)(ba + c0 + 4 * n), bxv = *(const f32x4*)(bx + c0 + 4 * n), spv = *(const f32x4*)(sp8 + c0 + 4 * n);
#pragma unroll
            for (int ai = 0; ai < 2; ++ai) {
                u32x2 uwv[4];
#pragma unroll
                for (int m = 0; m < 4; ++m) uwv[m] = *(const u32x2*)(UC + (size_t)(row0 + ai * 128 + m * 16) * DM + c0 + 4 * n);
                __builtin_amdgcn_sched_barrier(0);
#pragma unroll
                for (int m = 0; m < 4; ++m) { const size_t ro = (size_t)(row0 + ai * 128 + m * 16) * DM + c0 + 4 * n;
                    const float uc[4] = {bflo(uwv[m].x), bfhi(uwv[m].x), bflo(uwv[m].y), bfhi(uwv[m].y)};
                    f32x4 av, xv;
#pragma unroll
                    for (int j = 0; j < 4; ++j) {
                        const float r = sigmoidf_(acc[ai][0][m][n][j] + bav[j]), ig = sigmoidf_(acc[ai][1][m][n][j] + bxv[j]);
                        const float la = -r * spv[j], a = fexp(la), t = 2.f * la;
                        const float em = t * (1.f + t * (0.5f + t * (0.16666667f + t * (0.041666668f + t * 0.008333334f))));
                        av[j] = a; xv[j] = __builtin_sqrtf(fmaxf(-em, 0.f)) * ig * uc[j]; }
                    *(f32x4*)(A + ro) = av; *(f32x4*)(X + ro) = xv; __builtin_amdgcn_sched_barrier(0); } } }
    }
};

struct EpiMoeGU {
    bf16* ACT; const float* bgu;
    __device__ __forceinline__ void operator()(EPI_ARGS) const {
        const int row0 = u.pm * 256 + wr * 64 + fr, c0 = u.pn * 128 + wc * 32 + 8 * fq;
        const float* bb = bgu + (size_t)u.e * 2048 + c0;
        f32x4 bg[2], bl[2];
#pragma unroll
        for (int n = 0; n < 2; ++n) { bg[n] = *(const f32x4*)(bb + 4 * n); bl[n] = *(const f32x4*)(bb + 1024 + 4 * n); }
#pragma unroll
        for (int ai = 0; ai < 2; ++ai)
#pragma unroll
            for (int m = 0; m < 4; ++m) { const size_t ro = (size_t)(row0 + ai * 128 + m * 16) * DM + c0;
                f32x4 o[2];
#pragma unroll
                for (int n = 0; n < 2; ++n)
#pragma unroll
                    for (int j = 0; j < 4; ++j) {
                        const float glu = fminf(acc[ai][0][m][n][j] + bg[n][j], 7.f), lin = fminf(fmaxf(acc[ai][1][m][n][j] + bl[n][j], -7.f), 7.f);
                        o[n][j] = glu * frcp(1.f + fexp(-1.702f * glu)) * (lin + 1.f); }
                st_bf8(ACT + ro, o[0], o[1]); __builtin_amdgcn_sched_barrier(0); }
    }
};

struct EpiMoeDN {
    bf16* Y; const float* bdn; const unsigned* lent; const float* lgate; const LAS int* tab;
    __device__ __forceinline__ void operator()(EPI_ARGS) const {
        const int lb0 = u.e * 32768 + (u.pm - __builtin_amdgcn_readfirstlane(tab[u.e])) * 256;
        const int rl0 = wr * 64 + fr, col0 = u.pn * 256 + wc * 32 + 8 * fq;
        const float* bb = bdn + (size_t)u.e * 1024 + col0;
        f32x4 bv[2][2];
#pragma unroll
        for (int bj = 0; bj < 2; ++bj) { bv[bj][0] = *(const f32x4*)(bb + bj * 128); bv[bj][1] = *(const f32x4*)(bb + bj * 128 + 4); }
        unsigned entv[2][4]; float gtv[2][4];
#pragma unroll
        for (int ai = 0; ai < 2; ++ai)
#pragma unroll
            for (int m = 0; m < 4; ++m) { const int rl = rl0 + ai * 128 + m * 16; const bool ok = rl < u.nv; entv[ai][m] = ok ? lent[lb0 + rl] : 0u; gtv[ai][m] = ok ? lgate[lb0 + rl] : 0.f; }
        __builtin_amdgcn_sched_barrier(0);
#pragma unroll
        for (int ai = 0; ai < 2; ++ai)
#pragma unroll
            for (int m = 0; m < 4; ++m) { const int rl = rl0 + ai * 128 + m * 16;
                if (rl < u.nv) {
                    const unsigned ent = entv[ai][m]; const float gt = gtv[ai][m];
                    bf16* yo = Y + (size_t)ent * DM + col0;
#pragma unroll
                    for (int bj = 0; bj < 2; ++bj) st_bf8(yo + bj * 128, (acc[ai][bj][m][0] + bv[bj][0]) * gt, (acc[ai][bj][m][1] + bv[bj][1]) * gt); } }
    }
};

struct EpiPleA {
    bf16* PW; float* PSS;
    __device__ __forceinline__ void operator()(EPI_ARGS) const {
        const int row0 = u.pm * 256 + wr * 64 + fr, col0 = u.pn * 256 + wc * 32 + 8 * fq;
#pragma unroll
        for (int ai = 0; ai < 2; ++ai)
#pragma unroll
            for (int m = 0; m < 4; ++m) { const int row = row0 + ai * 128 + m * 16; const size_t ro = (size_t)row * DM;
                float ss = 0.f;
#pragma unroll
                for (int bj = 0; bj < 2; ++bj) { st_bf8(PW + ro + col0 + bj * 128, acc[ai][bj][m][0], acc[ai][bj][m][1]);
#pragma unroll
                    for (int n = 0; n < 2; ++n) { const f32x4 x = acc[ai][bj][m][n]; ss += (x[0] * x[0] + x[1] * x[1]) + (x[2] * x[2] + x[3] * x[3]); } }
                ss += sx<16>(ss); ss = add_x32(ss);
                if (fq == 0) PSS[(size_t)row * 16 + u.pn * 4 + wc] = ss; __builtin_amdgcn_sched_barrier(0); }
    }
};

struct EpiPleFin {
    const float* Hs; float* Out; const bf16* PW; const float* prstd; const float* pn;
    __device__ __forceinline__ void operator()(EPI_ARGS) const {
        const int row0 = u.pm * 256 + wr * 64 + fr, col0 = u.pn * 256 + wc * 32 + 8 * fq;
        f32x4 gv[2][2];
#pragma unroll
        for (int bj = 0; bj < 2; ++bj) { gv[bj][0] = *(const f32x4*)(pn + col0 + bj * 128); gv[bj][1] = *(const f32x4*)(pn + col0 + bj * 128 + 4); }
#pragma unroll
        for (int ai = 0; ai < 2; ++ai)
#pragma unroll
            for (int m = 0; m < 4; ++m) { const int row = row0 + ai * 128 + m * 16; const size_t ro = (size_t)row * DM; const float rs = prstd[row];
#pragma unroll
                for (int bj = 0; bj < 2; ++bj) { const size_t o = ro + col0 + bj * 128;
                    const u32x4 pw = *(const u32x4*)(PW + o); const f32x4 h0 = *(const f32x4*)(Hs + o), h1 = *(const f32x4*)(Hs + o + 4);
                    const f32x4 p0 = (f32x4){bflo(pw.x), bfhi(pw.x), bflo(pw.y), bfhi(pw.y)}, p1 = (f32x4){bflo(pw.z), bfhi(pw.z), bflo(pw.w), bfhi(pw.w)};
                    f32x4 s0, s1;
#pragma unroll
                    for (int j = 0; j < 4; ++j) { s0[j] = sigmoidf_(acc[ai][bj][m][0][j]); s1[j] = sigmoidf_(acc[ai][bj][m][1][j]); }
                    *(f32x4*)(Out + o) = h0 + p0 * rs * gv[bj][0] * s0; *(f32x4*)(Out + o + 4) = h1 + p1 * rs * gv[bj][1] * s1; } }
    }
};
#undef EPI_ARGS
}

struct Ctx {
    LAS unsigned char* lds; int tid, lane, wave, vcu, G, bid;
};
__device__ __forceinline__ Ctx make_ctx(unsigned char* lds_raw, int wave_s) {
    Ctx F; F.lds = (LAS unsigned char*)lds_raw; F.lane = hw_lane(); F.wave = wave_s; F.tid = wave_s * 64 + F.lane;
    F.G = gridDim.x; F.bid = blockIdx.x; F.vcu = (F.G % 8 == 0) ? (F.bid % 8) * (F.G / 8) + F.bid / 8 : F.bid; return F;
}

__device__ __forceinline__ void p0_item(const float* src, int pitch, int k0, int sc0, bf16* dst  , int dpitch, LAS float* scr, int lane) {
#pragma unroll 8
    for (int i = 0; i < 32; ++i) { const int kk = 2 * i + (lane >> 5); scr[kk * 33 + (lane & 31)] = src[(size_t)(k0 + kk) * pitch + sc0 + (lane & 31)]; }
    LDS_WAIT(); asm volatile("" ::: "memory");
    const int c = lane & 7;
#pragma unroll
    for (int j = 0; j < 4; ++j) { const int n = (lane >> 3) + 8 * j; const LAS float* s = scr + (8 * c) * 33 + n;
        u32x4 o; o.x = pk2(s[0 * 33], s[1 * 33]); o.y = pk2(s[2 * 33], s[3 * 33]); o.z = pk2(s[4 * 33], s[5 * 33]); o.w = pk2(s[6 * 33], s[7 * 33]);
        *(GAS u32x4*)(dst + (size_t)n * dpitch + 8 * c) = o; }
    LDS_WAIT(); asm volatile("" ::: "memory");
}

__device__ __forceinline__ void p0_prologue(const Ctx& F, CArgs* A) {
    LAS float* scr = (LAS float*)(F.lds + F.wave * 16384);
    const int gw = F.vcu * NWAVES + F.wave, NGW = F.G * NWAVES;
    unsigned char* ws = A->ws;
    constexpr int IT_GU = 128 * 16 * 64, IT_DN = 128 * 16 * 32, IT_HGIN = 2 * 16 * 128, IT_HGOUT = 2 * 16 * 32, IT_FOXIN = 16 * 128, IT_SQ = 16 * 32,
                  IT_RGIN = 16 * 64, IT_RGAX = 4 * 64, IT_PLE = 4 * 4 * 32, IT_PLEG = 4 * 16 * 32;
    constexpr int C0 = IT_GU, C1 = C0 + IT_DN, C2_ = C1 + IT_HGIN, C3 = C2_ + IT_HGOUT, C4 = C3 + IT_FOXIN, C5 = C4 + IT_SQ  , C6 = C5 + IT_RGIN, C7 = C6 + IT_RGAX,
                  C8 = C7 + IT_SQ  , C9 = C8 + IT_PLE, C10 = C9 + IT_PLEG;
    for (int it = gw; it < C10; it += NGW) {
        if (it < C0) {
            const int mi = it >> 10, r = it & 1023, kb = r >> 6, nb = r & 63, n0 = nb * 32;
            const int pn = n0 >> 8, bj = (n0 >> 7) & 1, c = n0 & 127, sc0 = bj * 1024 + pn * 128 + c;
            p0_item(A->in[I_GU_W] + (size_t)mi * 1024 * 2048, 2048, kb * 64, sc0, (bf16*)(ws + WS_W_GU) + (size_t)mi * 2048 * 1024 + (size_t)n0 * 1024 + kb * 64, 1024, scr, F.lane);
        } else if (it < C1) {
            const int r0 = it - C0, mi = r0 >> 9, r = r0 & 511, kb = r >> 5, n0 = (r & 31) * 32;
            p0_item(A->in[I_DN_W] + (size_t)mi * 1024 * 1024, 1024, kb * 64, n0, (bf16*)(ws + WS_W_DN) + (size_t)mi * 1024 * 1024 + (size_t)n0 * 1024 + kb * 64, 1024, scr, F.lane);
        } else if (it < C2_) {
            const int r0 = it - C1, mi = r0 >> 11, r = r0 & 2047, kb = r >> 7, n0 = (r & 127) * 32;
            p0_item(A->in[I_HG_WIN] + (size_t)mi * 1024 * 4096, 4096, kb * 64, n0, (bf16*)(ws + WS_W_HGIN) + (size_t)mi * 4096 * 1024 + (size_t)n0 * 1024 + kb * 64, 1024, scr, F.lane);
        } else if (it < C3) {
            const int r0 = it - C2_, mi = r0 >> 9, r = r0 & 511, kb = r >> 5, n0 = (r & 31) * 32;
            p0_item(A->in[I_HG_WOUT] + (size_t)mi * 1024 * 1024, 1024, kb * 64, n0, (bf16*)(ws + WS_W_HGOUT) + (size_t)mi * 1024 * 1024 + (size_t)n0 * 1024 + kb * 64, 1024, scr, F.lane);
        } else if (it < C4) {
            const int r = it - C3, kb = r >> 7, n0 = (r & 127) * 32; int sc0 = n0;
            if (n0 < 2048) { const int sec = n0 >> 10, pn = (n0 >> 8) & 3, bj = (n0 >> 7) & 1, wc = (n0 >> 5) & 3; sc0 = sec * 1024 + pn * 256 + wc * 64 + bj * 32; }
            p0_item(A->in[I_FOX_WIN], 4112, kb * 64, sc0, (bf16*)(ws + WS_W_FOXIN) + (size_t)n0 * 1024 + kb * 64, 1024, scr, F.lane);
        } else if (it < C5) {
            const int r = it - C4, kb = r >> 5, n0 = (r & 31) * 32;
            p0_item(A->in[I_FOX_WOUT], 1024, kb * 64, n0, (bf16*)(ws + WS_W_FOXOUT) + (size_t)n0 * 1024 + kb * 64, 1024, scr, F.lane);
        } else if (it < C6) {
            const int r = it - C5, kb = r >> 6, n0 = (r & 63) * 32;
            p0_item(A->in[I_RG_WIN], 2048, kb * 64, n0, (bf16*)(ws + WS_W_RGIN) + (size_t)n0 * 1024 + kb * 64, 1024, scr, F.lane);
        } else if (it < C7) {
            const int r = it - C6, kb = r >> 6, n0 = (r & 63) * 32, pn = n0 >> 8, bj = (n0 >> 7) & 1, c = n0 & 127;
            const float* src = (bj ? A->in[I_RG_WX] : A->in[I_RG_WA]) + (size_t)(pn >> 1) * 256 * 256;
            p0_item(src, 256, kb * 64, (pn & 1) * 128 + c, (bf16*)(ws + WS_W_RGAX) + (size_t)n0 * 256 + kb * 64, 256, scr, F.lane);
        } else if (it < C8) {
            const int r = it - C7, kb = r >> 5, n0 = (r & 31) * 32;
            p0_item(A->in[I_RG_WOUT], 1024, kb * 64, n0, (bf16*)(ws + WS_W_RGOUT) + (size_t)n0 * 1024 + kb * 64, 1024, scr, F.lane);
        } else if (it < C9) {
            const int r0 = it - C8, mi = r0 >> 7, r = r0 & 127, kb = r >> 5, n0 = (r & 31) * 32;
            p0_item(A->in[I_PLE_W] + (size_t)mi * 256 * 1024, 1024, kb * 64, n0, (bf16*)(ws + WS_W_PLE) + (size_t)mi * 1024 * 256 + (size_t)n0 * 256 + kb * 64, 256, scr, F.lane);
        } else {
            const int r0 = it - C9, mi = r0 >> 9, r = r0 & 511, kb = r >> 5, n0 = (r & 31) * 32;
            p0_item(A->in[I_PLE_GW] + (size_t)mi * 1024 * 1024, 1024, kb * 64, n0, (bf16*)(ws + WS_W_PLEG) + (size_t)mi * 1024 * 1024 + (size_t)n0 * 1024 + kb * 64, 1024, scr, F.lane);
        }
    }
    { const size_t n8 = (size_t)DEPTH * M * PLED / 8; const size_t gt = (size_t)F.vcu * NTHR + F.tid, NT = (size_t)F.G * NTHR;
      const f32x4* src = (const f32x4*)A->in[I_P]; u32x4* dst = (u32x4*)(ws + WS_PB);
      for (size_t i = gt; i < n8; i += NT) { const f32x4 a = src[2 * i], b = src[2 * i + 1]; u32x4 o; o.x = pk2(a[0], a[1]); o.y = pk2(a[2], a[3]); o.z = pk2(b[0], b[1]); o.w = pk2(b[2], b[3]); dst[i] = o; } }
    if (F.bid == 0) {
        float* sm = (float*)(ws + WS_SMALL);
        for (int d = F.tid; d < DM; d += NTHR) {
            const float* lp = A->in[I_HG_LB]; const float a0 = lp[d], a1 = lp[DM + d], a2 = lp[2 * DM + d], a3 = lp[3 * DM + d];
            const float mx = fmaxf(fmaxf(a0, a1), fmaxf(a2, a3)); const float e0 = __expf(a0 - mx), e1 = __expf(a1 - mx), e2 = __expf(a2 - mx), e3 = __expf(a3 - mx);
            const float inv = 1.f / (e0 + e1 + e2 + e3);
            sm[SM_LB0 / 4 + d] = 0.f; sm[SM_LB3 / 4 + d] = (e1 + e2 + e3) * inv;
            const float lam = A->in[I_RG_LAM][d]; const float sp = (-lam > 15.f) ? -lam : log1pf(__expf(-lam)); sm[SM_SP8 / 4 + d] = 8.f * sp;
        }
    }
}

__device__ __forceinline__ float row_load_rstd(const float* row, int lane, f32x4 (&v)[4]) {
    const GAS f32x4* xr = (const GAS f32x4*)row + lane; float s = 0.f;
#pragma unroll
    for (int j = 0; j < 4; ++j) { v[j] = xr[64 * j]; s += (v[j].x * v[j].x + v[j].y * v[j].y) + (v[j].z * v[j].z + v[j].w * v[j].w); }
    return __builtin_amdgcn_rsqf(wave_sum(s) * (1.f / DM) + EPS);
}
__device__ __forceinline__ void row_store_bf16(bf16* orow, int lane, const f32x4 (&v)[4], float rstd, const f32x4 (&g)[4]) {
    GAS u32x2* o8 = (GAS u32x2*)orow + lane;
#pragma unroll
    for (int j = 0; j < 4; ++j) { u32x2 w; w.x = pk2(v[j].x * rstd * g[j].x, v[j].y * rstd * g[j].y); w.y = pk2(v[j].z * rstd * g[j].z, v[j].w * rstd * g[j].w); o8[64 * j] = w; }
}
__device__ __forceinline__ void t1_plain(const Ctx& F, const float* H, const float* gain, bf16* XN) {
    const int gw = F.vcu * NWAVES + F.wave, NGW = F.G * NWAVES;
    f32x4 g[4];
#pragma unroll
    for (int j = 0; j < 4; ++j) g[j] = ((const f32x4*)gain)[F.lane + 64 * j];
    for (int m = gw; m < M; m += NGW) { f32x4 v[4]; const float rstd = row_load_rstd(H + (size_t)m * DM, F.lane, v); row_store_bf16(XN + (size_t)m * DM, F.lane, v, rstd, g); }
}

template <int NE> __device__ __forceinline__ int w_swz(int k) { return NE == 32 ? ((k >> 1) & 7) : ((k >> 2) & 3); }
template <int NE> __device__ __forceinline__ void load_w_lds(const Ctx& F, const float* W, int pitch, int col0) {
    constexpr int NQ = NE / 4; LAS float* wl = (LAS float*)F.lds;
    for (int idx = F.tid; idx < DM * NQ; idx += NTHR) { const int k = idx / NQ, q = idx % NQ; const f32x4 v = *(const f32x4*)(W + (size_t)k * pitch + col0 + 4 * q);
        *(LAS f32x4*)(wl + k * NE + ((q ^ w_swz<NE>(k)) * 4)) = v; }
}
template <int N, int DIST> struct RS { static __device__ __forceinline__ float run(const float (&a)[N], int lane) {
    float b[N / 2];
    if constexpr (DIST == 32) {
#pragma unroll
        for (int i = 0; i < N / 2; ++i) { float lo = a[i], hi = a[i + N / 2]; swap32(lo, hi); b[i] = lo + hi; }
    } else { const bool up = (lane & DIST) != 0;
#pragma unroll
        for (int i = 0; i < N / 2; ++i) { const float keep = up ? a[i + N / 2] : a[i], send = up ? a[i] : a[i + N / 2]; b[i] = keep + sx<DIST>(send); } }
    return RS<N / 2, DIST / 2>::run(b, lane); } };
template <int DIST> struct RS<1, DIST> { static __device__ __forceinline__ float run(const float (&a)[1], int lane) { float v = a[0];
    if constexpr (DIST >= 16) v += sx<16>(v); if constexpr (DIST >= 8) v += sx<8>(v); if constexpr (DIST >= 4) v += sx<4>(v); if constexpr (DIST >= 2) v += sx<2>(v); v += sx<1>(v); return v; } };
__device__ __forceinline__ void rows2_rstd(const float* r0p, const float* r1p, int lane, float& rs0, float& rs1) {
    float s0 = 0.f, s1 = 0.f;
#pragma unroll
    for (int jj = 0; jj < 16; ++jj) { const float a = r0p[lane + 64 * jj], b = r1p[lane + 64 * jj]; s0 += a * a; s1 += b * b; }
    rs0 = __builtin_amdgcn_rsqf(wave_sum(s0) * (1.f / DM) + EPS); rs1 = __builtin_amdgcn_rsqf(wave_sum(s1) * (1.f / DM) + EPS);
}
template <int NE> __device__ __forceinline__ void rows2_norm_proj(const LAS float* wl, const float* r0p, const float* r1p, const float* gain, bf16* o0, bf16* o1, float rs0, float rs1, int lane, float& r0, float& r1) {
    constexpr int NQ = NE / 4; float a0[NE], a1[NE];
#pragma unroll
    for (int e = 0; e < NE; ++e) { a0[e] = 0.f; a1[e] = 0.f; }
    const int sw = w_swz<NE>(lane);
#pragma unroll 2
    for (int jj = 0; jj < 16; ++jj) { const int k = lane + 64 * jj; const float gk = gain[k]; const float x0 = r0p[k] * rs0 * gk, x1 = r1p[k] * rs1 * gk;
        o0[k] = (bf16)f2bf(x0); o1[k] = (bf16)f2bf(x1);
        const LAS float* wrow = wl + k * NE;
#pragma unroll
        for (int q = 0; q < NQ; ++q) { const f32x4 w = *(const LAS f32x4*)(wrow + ((q ^ sw) * 4));
#pragma unroll
            for (int c = 0; c < 4; ++c) { a0[4 * q + c] += x0 * w[c]; a1[4 * q + c] += x1 * w[c]; } } }
    r0 = RS<NE, 32>::run(a0, lane); r1 = RS<NE, 32>::run(a1, lane);
}

__device__ __forceinline__ void t1_fox(const Ctx& F, const float* H, const float* gain, bf16* XN, const float* Wfox, const float* fbias, float* LSIG) {
    load_w_lds<16>(F, Wfox, 4112, 4096);
    const float fb = fbias[F.lane >> 2];
    __syncthreads();
    for (int rb = F.bid; rb < M / 128; rb += F.G) {
        const int rbase = rb * 128 + F.wave * 16;
        for (int pr = 0; pr < 8; ++pr) { const int m0 = rbase + 2 * pr;
            const float* r0p = H + (size_t)m0 * DM; const float* r1p = r0p + DM; float rs0, rs1, r0, r1; rows2_rstd(r0p, r1p, F.lane, rs0, rs1);
            rows2_norm_proj<16>((const LAS float*)F.lds, r0p, r1p, gain, XN + (size_t)m0 * DM, XN + (size_t)(m0 + 1) * DM, rs0, rs1, F.lane, r0, r1);
            if ((F.lane & 3) == 0) {
                const float z0 = r0 + fb, z1 = r1 + fb;
                LSIG[(size_t)m0 * 16 + (F.lane >> 2)] = fminf(z0, 0.f) - log1pf(__expf(-fabsf(z0)));
                LSIG[(size_t)(m0 + 1) * 16 + (F.lane >> 2)] = fminf(z1, 0.f) - log1pf(__expf(-fabsf(z1))); } } }
    __syncthreads();
}

__device__ __forceinline__ void t2_router(const Ctx& F, const float* H, const float* gain, bf16* XN, const float* Wr, const float* br, gu32* cnt, unsigned* LENT, float* LGATE) {
    LAS int* ent_e = (LAS int*)(F.lds + LDSX_OFF); LAS float* ent_g = (LAS float*)(F.lds + LDSX_OFF + 2048); LAS int* ent_li = (LAS int*)(F.lds + LDSX_OFF + 4096);
    LAS int* hist = (LAS int*)(F.lds + LDSX_OFF + 6144); LAS int* base = (LAS int*)(F.lds + LDSX_OFF + 6144 + 128);
    load_w_lds<32>(F, Wr, 32, 0);
    const float bias = br[F.lane >> 1];
    for (int rb = F.bid; rb < M / 128; rb += F.G) {
        if (F.tid < 32) hist[F.tid] = 0;
        __syncthreads();
        const int rl0 = F.wave * 16;
        for (int pr = 0; pr < 8; ++pr) { const int rl = rl0 + 2 * pr, m0 = rb * 128 + rl;
            const float* r0p = H + (size_t)m0 * DM; const float* r1p = r0p + DM; float rs0, rs1, r0, r1; rows2_rstd(r0p, r1p, F.lane, rs0, rs1);
            rows2_norm_proj<32>((const LAS float*)F.lds, r0p, r1p, gain, XN + (size_t)m0 * DM, XN + (size_t)(m0 + 1) * DM, rs0, rs1, F.lane, r0, r1);
#pragma unroll
            for (int rr = 0; rr < 2; ++rr) {
                float val = (rr == 0 ? r0 : r1) + bias; float tv[4]; int ti[4];
#pragma unroll
                for (int j = 0; j < 4; ++j) { const float mx = wave_max(val); const unsigned long long bl = __ballot(val == mx); const int first = __ffsll((long long)bl) - 1;
                    tv[j] = mx; ti[j] = first >> 1; if ((F.lane >> 1) == ti[j]) val = -INFINITY; }
                const float e1 = __expf(tv[1] - tv[0]), e2 = __expf(tv[2] - tv[0]), e3 = __expf(tv[3] - tv[0]); const float inv = 1.f / (1.f + e1 + e2 + e3);
                if (F.lane < 4) { const int j = F.lane; const int e = j == 0 ? ti[0] : j == 1 ? ti[1] : j == 2 ? ti[2] : ti[3]; const float gt = (j == 0 ? 1.f : j == 1 ? e1 : j == 2 ? e2 : e3) * inv;
                    const int li = __hip_atomic_fetch_add(hist + e, 1, __ATOMIC_RELAXED, __HIP_MEMORY_SCOPE_WORKGROUP);
                    const int slot = (rl + rr) * 4 + j; ent_e[slot] = e; ent_g[slot] = gt; ent_li[slot] = li; }
            } }
        __syncthreads();
        if (F.tid < 32) base[F.tid] = (int)__hip_atomic_fetch_add(cnt + F.tid, (unsigned)hist[F.tid], RLX_AGENT);
        __syncthreads();
        { const int t = F.tid, e = ent_e[t], pos = base[e] + ent_li[t]; LENT[(size_t)e * 32768 + pos] = (unsigned)((rb * 128 + (t >> 2)) * 4 + (t & 3)); LGATE[(size_t)e * 32768 + pos] = ent_g[t]; }
        __syncthreads();
    }
}

__device__ __forceinline__ void t3_combine(const Ctx& F, float* H, const bf16* Y, const float* gain, bf16* GN, const float* PSS, float* PRSTD) {
    const int gw = F.vcu * NWAVES + F.wave, NGW = F.G * NWAVES;
    f32x4 g[4];
#pragma unroll
    for (int j = 0; j < 4; ++j) g[j] = ((const f32x4*)gain)[F.lane + 64 * j];
    for (int m = gw; m < M; m += NGW) {
        GAS f32x4* hr = (GAS f32x4*)(H + (size_t)m * DM) + F.lane; f32x4 v[4]; float s = 0.f;
#pragma unroll
        for (int j = 0; j < 4; ++j) { v[j] = hr[64 * j];
#pragma unroll
            for (int k = 0; k < 4; ++k) { const u32x2 w = ((const GAS u32x2*)(Y + ((size_t)m * 4 + k) * DM))[F.lane + 64 * j]; v[j].x += bflo(w.x); v[j].y += bfhi(w.x); v[j].z += bflo(w.y); v[j].w += bfhi(w.y); }
            hr[64 * j] = v[j]; s += (v[j].x * v[j].x + v[j].y * v[j].y) + (v[j].z * v[j].z + v[j].w * v[j].w); }
        const float rstd = __builtin_amdgcn_rsqf(wave_sum(s) * (1.f / DM) + EPS);
        row_store_bf16(GN + (size_t)m * DM, F.lane, v, rstd, g);
        float ps = F.lane < 16 ? PSS[(size_t)m * 16 + F.lane] : 0.f; ps = wave_sum(ps);
        if (F.lane == 0) PRSTD[m] = __builtin_amdgcn_rsqf(ps * (1.f / DM) + EPS);
    }
}

__device__ __forceinline__ void rg_conv(const Ctx& F, const bf16* U, const float* cw, const float* cb, bf16* UC) {
    const int cg = (F.tid & 127) * 8, rq = F.tid >> 7;
    float w[4][8], b[8];
#pragma unroll
    for (int j = 0; j < 8; ++j) { b[j] = cb[cg + j];
#pragma unroll
        for (int t = 0; t < 4; ++t) w[t][j] = cw[t * DM + cg + j]; }
    for (int rb = F.bid; rb < M / 128; rb += F.G) {
        const int r0 = rb * 128 + rq * 32, t0 = r0 & (SEQ - 1);
        float p[3][8];
#pragma unroll
        for (int k = 0; k < 3; ++k) { const int dt = 3 - k;
            if (t0 - dt >= 0) { const u32x4 x = *(const u32x4*)(U + (size_t)(r0 - dt) * DM + cg); p[k][0] = bflo(x.x); p[k][1] = bfhi(x.x); p[k][2] = bflo(x.y); p[k][3] = bfhi(x.y); p[k][4] = bflo(x.z); p[k][5] = bfhi(x.z); p[k][6] = bflo(x.w); p[k][7] = bfhi(x.w); }
            else {
#pragma unroll
                for (int j = 0; j < 8; ++j) p[k][j] = 0.f; } }
#pragma unroll 4
        for (int r = 0; r < 32; ++r) { const u32x4 x = *(const u32x4*)(U + (size_t)(r0 + r) * DM + cg);
            float c[8] = {bflo(x.x), bfhi(x.x), bflo(x.y), bfhi(x.y), bflo(x.z), bfhi(x.z), bflo(x.w), bfhi(x.w)}; float o[8];
#pragma unroll
            for (int j = 0; j < 8; ++j) { o[j] = b[j] + p[0][j] * w[0][j] + p[1][j] * w[1][j] + p[2][j] * w[2][j] + c[j] * w[3][j]; p[0][j] = p[1][j]; p[1][j] = p[2][j]; p[2][j] = c[j]; }
            u32x4 ow; ow.x = pk2(o[0], o[1]); ow.y = pk2(o[2], o[3]); ow.z = pk2(o[4], o[5]); ow.w = pk2(o[6], o[7]); *(u32x4*)(UC + (size_t)(r0 + r) * DM + cg) = ow; }
    }
}
__device__ __forceinline__ void rg_scan1(const Ctx& F, const float* A, const float* X, float* SC) {
    const int c = 2 * F.tid;
    for (int rb = F.bid; rb < M / 128; rb += F.G) {
        float p0 = 1.f, p1 = 1.f, h0 = 0.f, h1 = 0.f; const size_t o = (size_t)rb * 128 * DM + c;
#pragma unroll 8
        for (int r = 0; r < 128; ++r) { const f32x2 a = *(const f32x2*)(A + o + (size_t)r * DM), x = *(const f32x2*)(X + o + (size_t)r * DM); h0 = a.x * h0 + x.x; h1 = a.y * h1 + x.y; p0 *= a.x; p1 *= a.y; }
        *(f32x4*)(SC + ((size_t)rb * DM + c) * 2) = (f32x4){p0, h0, p1, h1};
    }
}
__device__ __forceinline__ void rg_scan2(const Ctx& F, const float* A, const float* X, const float* SC, const bf16* GATE, bf16* OUT) {
    const int c = 2 * F.tid;
    for (int rb = F.bid; rb < M / 128; rb += F.G) {
        const int cb = rb & 63, b0 = rb - cb; float h0 = 0.f, h1 = 0.f;
        for (int cc = 0; cc < cb; ++cc) { const f32x4 s = *(const f32x4*)(SC + ((size_t)(b0 + cc) * DM + c) * 2); h0 = s.x * h0 + s.y; h1 = s.z * h1 + s.w; }
        const size_t o = (size_t)rb * 128 * DM + c;
#pragma unroll 8
        for (int r = 0; r < 128; ++r) { const f32x2 a = *(const f32x2*)(A + o + (size_t)r * DM), x = *(const f32x2*)(X + o + (size_t)r * DM); const unsigned gw = *(const unsigned*)(GATE + o + (size_t)r * DM);
            h0 = a.x * h0 + x.x; h1 = a.y * h1 + x.y; *(unsigned*)(OUT + o + (size_t)r * DM) = pk2(h0 * bflo(gw), h1 * bfhi(gw)); }
    }
}

__device__ __forceinline__ void fox_cum(const Ctx& F, const float* LSIG, float* FCUM, bf16* KC) {
    LAS float* wt = (LAS float*)(F.lds + LDSX_OFF);
    for (int bh = F.bid; bh < NB * FOXH; bh += F.G) {
        const int b = bh >> 4, hd = bh & 15, s0 = F.tid * 16; float v[16]; float run = 0.f;
#pragma unroll
        for (int i = 0; i < 16; ++i) { run += LSIG[((size_t)b * SEQ + s0 + i) * 16 + hd]; v[i] = run; }
        float inc = run;
#pragma unroll
        for (int o = 1; o < 64; o <<= 1) { const float t = __builtin_bit_cast(float, __builtin_amdgcn_ds_bpermute((F.lane - o) << 2, __builtin_bit_cast(int, inc))); if (F.lane >= o) inc += t; }
        if (F.lane == 63) wt[F.wave] = inc;
        __syncthreads();
        float off = inc - run;
        for (int w = 0; w < F.wave; ++w) off += wt[w];
        __syncthreads();
#pragma unroll
        for (int i = 0; i < 16; ++i) { const float c = v[i] + off; FCUM[(size_t)bh * SEQ + s0 + i] = c;
            const float nb = -c * 1.4426950408889634f; const unsigned h = f2bf(nb); const float r1 = nb - bf2f((unsigned short)h); const unsigned mm = f2bf(r1); const float r2 = r1 - bf2f((unsigned short)mm); const unsigned lo = f2bf(r2);
            u32x4 w; w.x = h | (mm << 16); w.y = lo | (0x3F80u << 16); w.z = 0x3F80u | (0x3F80u << 16); w.w = 0u;
            *(u32x4*)(KC + ((size_t)bh * SEQ + s0 + i) * 8) = w; }
    }
}

constexpr int HG_P128 = 136, HG_P64 = 72;
__device__ __forceinline__ void unpack8(const u32x4 w, float (&f)[8]) { f[0] = bflo(w.x); f[1] = bfhi(w.x); f[2] = bflo(w.y); f[3] = bfhi(w.y); f[4] = bflo(w.z); f[5] = bfhi(w.z); f[6] = bflo(w.w); f[7] = bfhi(w.w); }
__device__ __forceinline__ int crow32(int r, int hi) { return (r & 3) + 8 * (r >> 2) + 4 * hi; }

__device__ __forceinline__ void hg_unit_a(const Ctx& F, int u, float* LF, const bf16* Kk, const bf16* V, float* GT, float* DEC) {
    LAS float* CUM = (LAS float*)F.lds; LAS float* TOT = (LAS float*)(F.lds + 32768);
    LAS bf16* KET = (LAS bf16*)(F.lds + 36864); LAS bf16* VT = (LAS bf16*)(F.lds + 36864 + 128 * HG_P64 * 2);
    const int hd = u & 7, bc = u >> 3; const size_t m0 = (size_t)bc * 64; const int t = F.tid, row = t >> 3, c0 = (t & 7) * 16;
    const size_t go = (m0 + row) * DM + hd * 128 + c0;
    f32x4 lf[4];
#pragma unroll
    for (int j = 0; j < 4; ++j) lf[j] = *(const f32x4*)(LF + go + 4 * j);
    const u32x4 kw0 = *(const u32x4*)(Kk + go), kw1 = *(const u32x4*)(Kk + go + 8), vw0 = *(const u32x4*)(V + go), vw1 = *(const u32x4*)(V + go + 8);
#pragma unroll
    for (int j = 0; j < 4; ++j) *(LAS f32x4*)(CUM + row * 128 + c0 + 4 * j) = lf[j];
    __syncthreads();
    { const int d = t & 127, qd = t >> 7; float run = 0.f;
#pragma unroll
      for (int r = 0; r < 16; ++r) { run += CUM[(qd * 16 + r) * 128 + d]; CUM[(qd * 16 + r) * 128 + d] = run; }
      TOT[qd * 128 + d] = run;
      __syncthreads();
      float off = 0.f; for (int q = 0; q < qd; ++q) off += TOT[q * 128 + d];
      if (qd > 0) {
#pragma unroll
          for (int r = 0; r < 16; ++r) CUM[(qd * 16 + r) * 128 + d] += off; }
      __syncthreads();
      if (t < 128) DEC[(size_t)u * 128 + t] = fexp(CUM[63 * 128 + t]); }
    { float kf[16], vf[16]; unpack8(kw0, *(float(*)[8])&kf[0]); unpack8(kw1, *(float(*)[8])&kf[8]); unpack8(vw0, *(float(*)[8])&vf[0]); unpack8(vw1, *(float(*)[8])&vf[8]);
#pragma unroll
      for (int j = 0; j < 4; ++j) { const f32x4 cu = *(const LAS f32x4*)(CUM + row * 128 + c0 + 4 * j), cl = *(const LAS f32x4*)(CUM + 63 * 128 + c0 + 4 * j);
          *(f32x4*)(LF + go + 4 * j) = cu;
#pragma unroll
          for (int i = 0; i < 4; ++i) { const int d = c0 + 4 * j + i; KET[d * HG_P64 + row] = (bf16)f2bf(kf[4 * j + i] * fexp(cl[i] - cu[i])); VT[d * HG_P64 + row] = (bf16)f2bf(vf[4 * j + i]); } } }
    __syncthreads();
    { const int w = F.wave, vb = w >> 1, i = F.lane & 31, hi = F.lane >> 5; f32x16 acc0 = {}, acc1 = {};
#pragma unroll
      for (int ks = 0; ks < 4; ++ks) { const bf16x8 a = *(const LAS bf16x8*)(VT + (vb * 32 + i) * HG_P64 + 16 * ks + 8 * hi);
          const bf16x8 b0 = *(const LAS bf16x8*)(KET + ((2 * (w & 1)) * 32 + i) * HG_P64 + 16 * ks + 8 * hi), b1 = *(const LAS bf16x8*)(KET + ((2 * (w & 1) + 1) * 32 + i) * HG_P64 + 16 * ks + 8 * hi);
          acc0 = __builtin_amdgcn_mfma_f32_32x32x16_bf16(a, b0, acc0, 0, 0, 0); acc1 = __builtin_amdgcn_mfma_f32_32x32x16_bf16(a, b1, acc1, 0, 0, 0); }
      float* g = GT + (size_t)u * 16384;
#pragma unroll
      for (int r = 0; r < 16; ++r) { const int v = vb * 32 + crow32(r, hi); g[v * 128 + (2 * (w & 1)) * 32 + i] = acc0[r]; g[v * 128 + (2 * (w & 1) + 1) * 32 + i] = acc1[r]; } }
    __syncthreads();
}

__device__ __forceinline__ void hg_scan_b(const Ctx& F, const float* GT, const float* DEC, bf16* ST) {
    for (int w = F.bid; w < 256; w += F.G) {
        const int bh = w >> 3, vb = w & 7, b = bh >> 3, hd = bh & 7, v = vb * 16 + (F.tid >> 5), d4 = (F.tid & 31) * 4;
        f32x4 s = {0.f, 0.f, 0.f, 0.f};
#pragma unroll 4
        for (int c = 0; c < 128; ++c) { const size_t u = (size_t)(b * 128 + c) * 8 + hd; const size_t o = (u * 128 + v) * 128 + d4;
            const f32x4 g = *(const f32x4*)(GT + o), dc = *(const f32x4*)(DEC + u * 128 + d4);
            u32x2 wv; wv.x = pk2(s.x, s.y); wv.y = pk2(s.z, s.w); *(u32x2*)(ST + o) = wv;
            s = dc * s + g; }
    }
}

__device__ __forceinline__ void hg_unit_c(const Ctx& F, int u, const float* CUMG, const bf16* Q, const bf16* Kk, const bf16* V, const bf16* G, const bf16* ST, const float* gnorm, bf16* OUT) {
    LAS float* CUM = (LAS float*)F.lds;
    LAS bf16* QD = (LAS bf16*)(F.lds + 32768); LAS bf16* KD = (LAS bf16*)(F.lds + 50176); LAS bf16* Q2 = (LAS bf16*)(F.lds + 67584);
    LAS bf16* Q1 = (LAS bf16*)(F.lds + 84992); LAS bf16* K1 = (LAS bf16*)(F.lds + 93696); LAS bf16* VT = (LAS bf16*)(F.lds + 102400); LAS bf16* P = (LAS bf16*)(F.lds + 120832);
    LAS float* O = (LAS float*)F.lds;
    const int hd = u & 7, bc = u >> 3; const size_t m0 = (size_t)bc * 64; const int t = F.tid, row = t >> 3, c0 = (t & 7) * 16;
    const size_t go = (m0 + row) * DM + hd * 128 + c0;
    const int w = F.wave, lane = F.lane;
    f32x4 cu[4];
#pragma unroll
    for (int j = 0; j < 4; ++j) cu[j] = *(const f32x4*)(CUMG + go + 4 * j);
    const u32x4 qw0 = *(const u32x4*)(Q + go), qw1 = *(const u32x4*)(Q + go + 8), kw0 = *(const u32x4*)(Kk + go), kw1 = *(const u32x4*)(Kk + go + 8), vw0 = *(const u32x4*)(V + go), vw1 = *(const u32x4*)(V + go + 8);
    const int tb = w >> 2, vb = w & 3, li = lane & 31, hi = lane >> 5;
    bf16x8 sfr[8];
    { const bf16* sp = ST + ((size_t)u * 128 + vb * 32 + li) * 128 + 8 * hi;
#pragma unroll
      for (int ks = 0; ks < 8; ++ks) sfr[ks] = *(const bf16x8*)(sp + 16 * ks); }
#pragma unroll
    for (int j = 0; j < 4; ++j) *(LAS f32x4*)(CUM + row * 128 + c0 + 4 * j) = cu[j];
    { float vf[16]; unpack8(vw0, *(float(*)[8])&vf[0]); unpack8(vw1, *(float(*)[8])&vf[8]);
#pragma unroll
      for (int i = 0; i < 16; ++i) VT[(c0 + i) * HG_P64 + row] = (bf16)f2bf(vf[i]); }
    for (int i = t; i < 64 * HG_P64 / 8; i += NTHR) *(LAS u32x4*)(P + i * 8) = (u32x4){0u, 0u, 0u, 0u};
    __syncthreads();
    { float qf[16], kf[16]; unpack8(qw0, *(float(*)[8])&qf[0]); unpack8(qw1, *(float(*)[8])&qf[8]); unpack8(kw0, *(float(*)[8])&kf[0]); unpack8(kw1, *(float(*)[8])&kf[8]);
      const int sub = row >> 5, midr = sub * 32 + 15;
      float oqd[16], okd[16], oq2[16], ox[16];
#pragma unroll
      for (int j = 0; j < 4; ++j) { const f32x4 md = *(const LAS f32x4*)(CUM + midr * 128 + c0 + 4 * j), b1 = *(const LAS f32x4*)(CUM + 31 * 128 + c0 + 4 * j);
#pragma unroll
          for (int i = 0; i < 4; ++i) { const float c = cu[j][i]; const int e = 4 * j + i;
              oqd[e] = qf[e] * fexp(c - md[i]); okd[e] = kf[e] * fexp(md[i] - c); oq2[e] = qf[e] * fexp(c);
              ox[e] = sub ? qf[e] * fexp(c - b1[i]) : kf[e] * fexp(b1[i] - c); } }
#define HG_ST16(dst, src) do { u32x4 a_, b_; a_.x = pk2(src[0], src[1]); a_.y = pk2(src[2], src[3]); a_.z = pk2(src[4], src[5]); a_.w = pk2(src[6], src[7]); b_.x = pk2(src[8], src[9]); b_.y = pk2(src[10], src[11]); b_.z = pk2(src[12], src[13]); b_.w = pk2(src[14], src[15]); \
          *(LAS u32x4*)(dst) = a_; *(LAS u32x4*)((dst) + 8) = b_; } while (0)
      HG_ST16(QD + row * HG_P128 + c0, oqd); HG_ST16(KD + row * HG_P128 + c0, okd); HG_ST16(Q2 + row * HG_P128 + c0, oq2);
      if (sub) { HG_ST16(Q1 + (row - 32) * HG_P128 + c0, ox); } else { HG_ST16(K1 + row * HG_P128 + c0, ox); }
#undef HG_ST16
    }
    __syncthreads();
    { const int fr = lane & 15, kg = lane >> 4;
      for (int bi = w; bi < 10; bi += 8) {
          int I = 0, J = 0; { int k = bi; while (k > I) { k -= I + 1; ++I; } J = k; }
          const bool diag = (I >> 1) == (J >> 1);
          const LAS bf16* ap = diag ? QD + (16 * I + fr) * HG_P128 : Q1 + (16 * I - 32 + fr) * HG_P128;
          const LAS bf16* bp = diag ? KD + (16 * J + fr) * HG_P128 : K1 + (16 * J + fr) * HG_P128;
          f32x4 acc = {0.f, 0.f, 0.f, 0.f};
#pragma unroll
          for (int ks = 0; ks < 4; ++ks) { const bf16x8 a = *(const LAS bf16x8*)(ap + 32 * ks + 8 * kg), b = *(const LAS bf16x8*)(bp + 32 * ks + 8 * kg); acc = __builtin_amdgcn_mfma_f32_16x16x32_bf16(a, b, acc, 0, 0, 0); }
#pragma unroll
          for (int r = 0; r < 4; ++r) { const int tt = 16 * I + 4 * kg + r, ss = 16 * J + fr; const float x = (I == J && ss > tt) ? 0.f : acc[r]; P[tt * HG_P64 + ss] = (bf16)f2bf(x); } } }
    __syncthreads();
    f32x16 o = {};
    {
#pragma unroll
      for (int ks = 0; ks < 4; ++ks) { const bf16x8 a = *(const LAS bf16x8*)(P + (tb * 32 + li) * HG_P64 + 16 * ks + 8 * hi), b = *(const LAS bf16x8*)(VT + (vb * 32 + li) * HG_P64 + 16 * ks + 8 * hi);
          o = __builtin_amdgcn_mfma_f32_32x32x16_bf16(a, b, o, 0, 0, 0); }
#pragma unroll
      for (int ks = 0; ks < 8; ++ks) { const bf16x8 a = *(const LAS bf16x8*)(Q2 + (tb * 32 + li) * HG_P128 + 16 * ks + 8 * hi); o = __builtin_amdgcn_mfma_f32_32x32x16_bf16(a, sfr[ks], o, 0, 0, 0); } }
    __syncthreads();
#pragma unroll
    for (int r = 0; r < 16; ++r) O[(tb * 32 + crow32(r, hi)) * 132 + vb * 32 + li] = o[r];
    __syncthreads();
    { float x[16]; float ss = 0.f;
#pragma unroll
      for (int j = 0; j < 4; ++j) { const f32x4 v4 = *(const LAS f32x4*)(O + row * 132 + c0 + 4 * j); x[4 * j] = v4.x; x[4 * j + 1] = v4.y; x[4 * j + 2] = v4.z; x[4 * j + 3] = v4.w; ss += (v4.x * v4.x + v4.y * v4.y) + (v4.z * v4.z + v4.w * v4.w); }
      ss += sx<1>(ss); ss += sx<2>(ss); ss += sx<4>(ss);
      const float rstd = __builtin_amdgcn_rsqf(ss * (1.f / 128.f) + EPS);
      const u32x4 gw0 = *(const u32x4*)(G + go), gw1 = *(const u32x4*)(G + go + 8); float gf[16]; unpack8(gw0, *(float(*)[8])&gf[0]); unpack8(gw1, *(float(*)[8])&gf[8]);
      float y[16];
#pragma unroll
      for (int i = 0; i < 16; ++i) y[i] = x[i] * rstd * gnorm[c0 + i] * gf[i];
      u32x4 a_, b_; a_.x = pk2(y[0], y[1]); a_.y = pk2(y[2], y[3]); a_.z = pk2(y[4], y[5]); a_.w = pk2(y[6], y[7]); b_.x = pk2(y[8], y[9]); b_.y = pk2(y[10], y[11]); b_.z = pk2(y[12], y[13]); b_.w = pk2(y[14], y[15]);
      *(u32x4*)(OUT + go) = a_; *(u32x4*)(OUT + go + 8) = b_; }
    __syncthreads();
}
namespace attn_body {
using bf16=__hip_bfloat16;
using bf16x8=__attribute__((ext_vector_type(8)))short;
using s16x4=__attribute__((ext_vector_type(4)))short;
using f32x16=__attribute__((ext_vector_type(16)))float;
using u32x4=__attribute__((ext_vector_type(4)))unsigned;
constexpr int BATCH=4,NHEAD=16,SEQ=8192,D=64,DM=NHEAD*D;
constexpr int NW=8,QBLK=32,QB=QBLK*NW,KVBLK=64,NQB=SEQ/QB;
constexpr int ATTN_PITCH=DM, ATTN_UNIT_ROWS=QB;
__device__ __forceinline__ int crow(int r,int hi){return (r&3)+8*(r>>2)+4*hi;}
#define SBAR() __builtin_amdgcn_sched_barrier(0)
__device__ __forceinline__ void cmask(f32x16&p0,f32x16&p1,int jb,int qrel,int hi){
  const float NEG=-INFINITY; int kb=64*jb+4*hi;
  #pragma unroll
  for(int r=0;r<16;++r){int kv=kb+(r&3)+8*(r>>2); if(kv>qrel)p0[r]=NEG; if(kv+32>qrel)p1[r]=NEG;}
}

constexpr int NSLOT=3, SLOTB=8192;
constexpr int CSLOTB=2048;
constexpr int LDS_K=0, LDS_V=NSLOT*SLOTB, LDS_C=2*NSLOT*SLOTB, LDS_WS=LDS_C+NSLOT*CSLOTB, LDS_OST=LDS_WS+NW*64*4, LDS_BYTES=LDS_OST+NW*4096;
constexpr float C2=0.125f*1.4426950408889634f;
__device__ __forceinline__ void glds16(const void*gsrc,unsigned lds_dst){unsigned keep;
  asm volatile("s_mov_b32 %0, m0\n\ts_mov_b32 m0, %2\n\ts_nop 0\n\tglobal_load_lds_dwordx4 %1, off\n\ts_mov_b32 m0, %0":"=&s"(keep):"v"(gsrc),"s"(lds_dst):"memory");}
__device__ __forceinline__ void glds16s(const void*sbase,unsigned voff,unsigned lds_dst){unsigned keep;
  asm volatile("s_mov_b32 %0, m0\n\ts_mov_b32 m0, %3\n\ts_nop 0\n\tglobal_load_lds_dwordx4 %1, %2\n\ts_mov_b32 m0, %0":"=&s"(keep):"v"(voff),"s"(sbase),"s"(lds_dst):"memory");}
__device__ __forceinline__ void glds4s(const void*sbase,unsigned voff,unsigned lds_dst){unsigned keep;
  asm volatile("s_mov_b32 %0, m0\n\ts_mov_b32 m0, %3\n\ts_nop 0\n\tglobal_load_lds_dword %1, %2\n\ts_mov_b32 m0, %0":"=&s"(keep):"v"(voff),"s"(sbase),"s"(lds_dst):"memory");}
__device__ __forceinline__ float max3f(float a,float b,float c){float r;asm("v_max3_f32 %0, %1, %2, %3":"=v"(r):"v"(a),"v"(b),"v"(c));return r;}
__device__ __forceinline__ float max2f(float a,float b){float r;asm("v_max_f32_e32 %0, %1, %2":"=v"(r):"v"(a),"v"(b));return r;}
__device__ __forceinline__ float fadd_s(float a,float b){float r;asm("v_add_f32_e32 %0, %1, %2":"=v"(r):"v"(a),"v"(b));return r;}
__device__ __forceinline__ float fsub_s(float a,float b){float r;asm("v_sub_f32_e32 %0, %1, %2":"=v"(r):"v"(a),"v"(b));return r;}
typedef float f32x2_t __attribute__((ext_vector_type(2))); typedef __bf16 bf16x2_t __attribute__((ext_vector_type(2)));
__device__ __forceinline__ unsigned cvtpk_s(float lo,float hi){f32x2_t v={lo,hi};bf16x2_t b=__builtin_convertvector(v,bf16x2_t);return __builtin_bit_cast(unsigned,b);}
#define WAIT_BAR(N) asm volatile("s_waitcnt vmcnt(" #N ") lgkmcnt(0)\n\ts_barrier":::"memory")

__device__ __forceinline__ void qkt(f32x16&p0,f32x16&p1,const char*Kslot,const char*Cslot,const bf16x8*qr,const bf16x8 qx,int r32,int hi){
  const char*kb=Kslot+hi*1024+r32*16; const f32x16 zz=f32x16{};
  #pragma unroll
  for(int d0=0;d0<4;++d0){
    const bf16x8 b0=*reinterpret_cast<const bf16x8*>(kb+d0*2048);
    const bf16x8 b1=*reinterpret_cast<const bf16x8*>(kb+d0*2048+512);
    if(d0==0){p0=__builtin_amdgcn_mfma_f32_32x32x16_bf16(b0,qr[0],zz,0,0,0);p1=__builtin_amdgcn_mfma_f32_32x32x16_bf16(b1,qr[0],zz,0,0,0);}
    else{p0=__builtin_amdgcn_mfma_f32_32x32x16_bf16(b0,qr[d0],p0,0,0,0);p1=__builtin_amdgcn_mfma_f32_32x32x16_bf16(b1,qr[d0],p1,0,0,0);}}
  { const bf16x8 c0=*reinterpret_cast<const bf16x8*>(Cslot+r32*16), c1=*reinterpret_cast<const bf16x8*>(Cslot+512+r32*16);
    p0=__builtin_amdgcn_mfma_f32_32x32x16_bf16(c0,qx,p0,0,0,0);p1=__builtin_amdgcn_mfma_f32_32x32x16_bf16(c1,qx,p1,0,0,0); }
}
__device__ __forceinline__ unsigned bf_rne(float f){unsigned u=__builtin_bit_cast(unsigned,f);return (u+0x7fffu+((u>>16)&1u))>>16;}
__device__ __forceinline__ bf16x8 make_qx(float mhat,int hi){
  const float v=-mhat; const unsigned h=bf_rne(v); const float r1=v-__builtin_bit_cast(float,h<<16); const unsigned m=bf_rne(r1); const float r2=r1-__builtin_bit_cast(float,m<<16); const unsigned l=bf_rne(r2);
  u32x4 w; w.x=hi?0u:(0x3F80u|(0x3F80u<<16)); w.y=hi?0u:(0x3F80u|(h<<16)); w.z=hi?0u:(m|(l<<16)); w.w=0u; return __builtin_bit_cast(bf16x8,w);
}
typedef __attribute__((address_space(3))) const char* lds_cptr;
typedef short v4i16_t __attribute__((ext_vector_type(4)));
__device__ __forceinline__ void kload8(bf16x8*kf,lds_cptr kp){
  kf[0]=*(const __attribute__((address_space(3))) bf16x8*)(kp);      kf[1]=*(const __attribute__((address_space(3))) bf16x8*)(kp+512);
  kf[2]=*(const __attribute__((address_space(3))) bf16x8*)(kp+2048); kf[3]=*(const __attribute__((address_space(3))) bf16x8*)(kp+2560);
  kf[4]=*(const __attribute__((address_space(3))) bf16x8*)(kp+4096); kf[5]=*(const __attribute__((address_space(3))) bf16x8*)(kp+4608);
  kf[6]=*(const __attribute__((address_space(3))) bf16x8*)(kp+6144); kf[7]=*(const __attribute__((address_space(3))) bf16x8*)(kp+6656);
}
__device__ __forceinline__ void cload2(bf16x8*kc,lds_cptr cp){ kc[0]=*(const __attribute__((address_space(3))) bf16x8*)(cp); kc[1]=*(const __attribute__((address_space(3))) bf16x8*)(cp+512); }
__device__ __forceinline__ void kload2(bf16x8*kf,lds_cptr kp,int j){ kf[2*j]=*(const __attribute__((address_space(3))) bf16x8*)(kp+j*2048); kf[2*j+1]=*(const __attribute__((address_space(3))) bf16x8*)(kp+j*2048+512); }
__device__ __forceinline__ s16x4 vtr(lds_cptr p){ return __builtin_bit_cast(s16x4,__builtin_amdgcn_ds_read_tr16_b64_v4i16((__attribute__((address_space(3))) v4i16_t*)p)); }
__device__ __forceinline__ float rowmax(const f32x16&p0,const f32x16&p1){
  float a=max3f(p0[0],p0[1],p1[0]),b=max3f(p0[2],p0[3],p1[1]);a=max3f(a,p1[2],p1[3]);
  #pragma unroll
  for(int r=4;r<16;r+=4){a=max3f(a,p0[r],p0[r+1]);b=max3f(b,p0[r+2],p0[r+3]);a=max3f(a,p1[r],p1[r+1]);b=max3f(b,p1[r+2],p1[r+3]);}
  const float m=max2f(a,b);
  return max_x32(m);
}
__device__ __forceinline__ void pv(f32x16*o,int vb,bf16x8 pa0,bf16x8 pa1,bf16x8 pa2,bf16x8 pa3){
  #pragma unroll
  for(int d0=0;d0<2;++d0){s16x4 lo[4],hi[4];
    #pragma unroll
    for(int ks=0;ks<4;++ks){
      asm volatile("ds_read_b64_tr_b16 %0,%1 offset:%c2":"=&v"(lo[ks]):"v"(vb),"i"(d0*4096+ks*1024):"memory");
      asm volatile("ds_read_b64_tr_b16 %0,%1 offset:%c2":"=&v"(hi[ks]):"v"(vb),"i"(d0*4096+ks*1024+512):"memory");}
    asm volatile("s_waitcnt lgkmcnt(0)":::"memory");SBAR();
    #define PK(k) (bf16x8){lo[k][0],lo[k][1],lo[k][2],lo[k][3],hi[k][0],hi[k][1],hi[k][2],hi[k][3]}
    o[d0]=__builtin_amdgcn_mfma_f32_32x32x16_bf16(pa0,PK(0),o[d0],0,0,0);
    o[d0]=__builtin_amdgcn_mfma_f32_32x32x16_bf16(pa1,PK(1),o[d0],0,0,0);
    o[d0]=__builtin_amdgcn_mfma_f32_32x32x16_bf16(pa2,PK(2),o[d0],0,0,0);
    o[d0]=__builtin_amdgcn_mfma_f32_32x32x16_bf16(pa3,PK(3),o[d0],0,0,0);
    #undef PK
  }
}

#ifndef ATTN_STORE16
#define ATTN_STORE16(p,v) (*(u32x4*)(p)=(v))
#endif
template<int THRL> __device__ __forceinline__ void attn_unit(int wave_s,int b,int h,int qb,const bf16*Q,const bf16*__restrict__ K,const bf16*__restrict__ V,const bf16*__restrict__ KC,const bf16*__restrict__ GT,bf16*O,char*shm){
  const int lane=hw_lane(),r32=lane&31,hi=lane>>5; const int wid=wave_s;
  const long rowbase=(long)b*SEQ; const int q0=qb*QB;
  const bf16*Qw=Q+(rowbase+q0+wid*QBLK)*DM+h*D;
  const bf16*Kh=K+rowbase*DM+h*D,*Vh=V+rowbase*DM+h*D;
  const unsigned lds0=(unsigned)(uintptr_t)shm;
  float*wsf=(float*)(shm+LDS_WS)+wid*64;
  const unsigned koff=(unsigned)(lane*DM+wid*8)*2u;
  const unsigned voff=(unsigned)((16*(wid&3)+(lane>>2))*DM+(wid>>2)*32+(lane&3)*8)*2u;
  const unsigned kdst=lds0+LDS_K+wid*1024, vdst=lds0+LDS_V+wid*1024, cdst=lds0+LDS_C+wid*256;
  const char*cbase=(const char*)KC+((long)(b*NHEAD+h)*SEQ)*16; const unsigned coff=(unsigned)((wid&3)*256+lane*4);
  #define DMA_K(t,slot) do{ glds16s(Kh+(long)(t)*KVBLK*DM,koff,(unsigned)__builtin_amdgcn_readfirstlane(kdst+(slot))); glds4s(cbase+(long)(t)*1024,coff,(unsigned)__builtin_amdgcn_readfirstlane(cdst+((slot)>>2))); }while(0)
  #define DMA_V(t,slot) glds16s(Vh+(long)(t)*KVBLK*DM,voff,(unsigned)__builtin_amdgcn_readfirstlane(vdst+(slot)))
  const int vb0=(int)(lds0+LDS_V)+((lane>>4)&1)*32+(lane&3)*8+(4*hi+((lane&15)>>2))*64;
  const char*Kbase=shm+LDS_K; const char*Cbase=shm+LDS_C; bf16x8 kf[8]; bf16x8 kc[2];
  const lds_cptr shm3=(lds_cptr)shm; const lds_cptr kp0=shm3+LDS_K+hi*1024+r32*16; const lds_cptr cp0=shm3+LDS_C+r32*16; const lds_cptr vp0=shm3+LDS_V+((lane>>4)&1)*32+(lane&3)*8+(4*hi+((lane&15)>>2))*64;
  const int NT=(q0+QB)/KVBLK;
  DMA_K(0,0);DMA_V(0,0);DMA_K(1,SLOTB);
  bf16x8 qr[4];
  #pragma unroll
  for(int d0=0;d0<4;++d0)qr[d0]=*reinterpret_cast<const bf16x8*>(&Qw[(long)r32*DM+d0*16+hi*8]);
  float mhat=0.f,l_reg=0.f;f32x16 o[2];o[0]=f32x16{};o[1]=f32x16{};bf16x8 qx=make_qx(0.f,hi); const f32x16 zz=f32x16{};
  const int qrel=wid*QBLK+r32;
  #define CMASK(P0,P1,t) do{int jb_=(t)-(NT-4); if(jb_>=0)cmask(P0,P1,jb_,qrel,hi);}while(0)
  bool resc=false;
  #define START(P0,P1) do{ const float rm=rowmax(P0,P1); resc=false; \
    { const float dl=rm; mhat=fadd_s(mhat,dl); \
      _Pragma("unroll") for(int r=0;r<16;++r){P0[r]=fsub_s(P0[r],dl);P1[r]=fsub_s(P1[r],dl);} \
      qx=make_qx(mhat,hi); } \
    _Pragma("unroll") for(int r=0;r<16;++r)P0[r]=__builtin_amdgcn_exp2f(P0[r]); }while(0)
  #define RESC() do{ if(resc){ asm volatile("s_waitcnt lgkmcnt(0)":::"memory"); \
      _Pragma("unroll") for(int d_=0;d_<2;++d_) _Pragma("unroll") for(int r=0;r<16;++r)o[d_][r]*=wsf[crow(r,hi)]; } }while(0)
  f32x16 pA0,pA1,pB0,pB1;
  int sl_prev=0,sl_cur=0,sl_next=SLOTB;
  #define ROT() do{sl_prev=sl_cur;sl_cur=sl_next;sl_next=(sl_next==(NSLOT-1)*SLOTB)?0:sl_next+SLOTB;}while(0)
  DMA_K(2,2*SLOTB);
  WAIT_BAR(5);
  qkt(pA0,pA1,Kbase,Cbase,qr,qx,r32,hi);asm volatile("s_nop 15\n\ts_nop 7":"+v"(pA0),"+v"(pA1));CMASK(pA0,pA1,0);
  START(pA0,pA1);
  _Pragma("unroll") for(int r=0;r<16;++r)pA1[r]=__builtin_amdgcn_exp2f(pA1[r]);
  WAIT_BAR(0);
  DMA_K(3,0);DMA_V(1,SLOTB);
  ROT();
  kload8(kf,kp0+sl_cur); cload2(kc,cp0+(sl_cur>>2));
  WAIT_BAR(3);
  s16x4 vlo[8],vhi[8]; u32x4 pw0,pw1,pw2,pw3;
  #define PKW(P,B) cvtpk_s(P[B],P[B+1])
  #define PAF(k) __builtin_bit_cast(bf16x8,pw##k)
  #define VFR(i) (bf16x8){vlo[i][0],vlo[i][1],vlo[i][2],vlo[i][3],vhi[i][0],vhi[i][1],vhi[i][2],vhi[i][3]}
  #define PIN(x) asm volatile("":"+v"(x))
  #define MX3(a,b,c) __builtin_fmaxf(__builtin_fmaxf((a),(b)),(c))
  #define GAPA(MF,A0,A1,A2,A3,W0,W1,PW) do{ MF; sacc+=A0; sacc+=A1; sacc+=A2; sacc+=A3; PIN(sacc); W0; W1; PIN(PW); SBAR(); }while(0)
  #define EX(v) __builtin_amdgcn_exp2f(v)
  #define GAPB(MF,X,B) do{ MF; X[B]=EX(X[B]); X[B+1]=EX(X[B+1]); X[B+2]=EX(X[B+2]); X[B+3]=EX(X[B+3]); PIN(X); SBAR(); }while(0)
  #define VRD(i) do{ vlo[i]=vtr(vp_+(((i)>>2)*4096+((i)&3)*1024)); vhi[i]=vtr(vp_+(((i)>>2)*4096+((i)&3)*1024+512)); }while(0)
  #define KRD(G,j) do{ if(G){ kload2(kf,kp0+sl_next,j); SBAR(); } }while(0)
  #define STEP(C0,C1,P0,P1,t,GK,GV,GL) do{ SBAR(); \
    const lds_cptr vp_=vp0+sl_prev; \
    VRD(0); SBAR(); float sacc=(P0[0]+P0[1]); \
    C0=__builtin_amdgcn_mfma_f32_32x32x16_bf16(kc[0],qx,zz,0,0,0); C1=__builtin_amdgcn_mfma_f32_32x32x16_bf16(kc[1],qx,zz,0,0,0); SBAR(); \
    GAPA(C0=__builtin_amdgcn_mfma_f32_32x32x16_bf16(kf[0],qr[0],C0,0,0,0), P0[2],P0[3],P0[4],P0[5],     pw0[0]=PKW(P0,0), pw0[1]=PKW(P0,2), pw0); \
    VRD(4); SBAR(); GAPA(C1=__builtin_amdgcn_mfma_f32_32x32x16_bf16(kf[1],qr[0],C1,0,0,0), P0[6],P0[7],P0[8],P0[9],     pw0[2]=PKW(P0,4), pw0[3]=PKW(P0,6), pw0); \
    VRD(1); SBAR(); GAPA(C0=__builtin_amdgcn_mfma_f32_32x32x16_bf16(kf[2],qr[1],C0,0,0,0),   P0[10],P0[11],P0[12],P0[13], pw1[0]=PKW(P0,8), pw1[1]=PKW(P0,10), pw1); \
    VRD(5); SBAR(); GAPA(C1=__builtin_amdgcn_mfma_f32_32x32x16_bf16(kf[3],qr[1],C1,0,0,0),   P0[14],P0[15],P1[0],P1[1],   pw1[2]=PKW(P0,12),pw1[3]=PKW(P0,14), pw1); \
    VRD(2); SBAR(); GAPA(C0=__builtin_amdgcn_mfma_f32_32x32x16_bf16(kf[4],qr[2],C0,0,0,0),   P1[2],P1[3],P1[4],P1[5],     pw2[0]=PKW(P1,0), pw2[1]=PKW(P1,2), pw2); \
    VRD(6); SBAR(); GAPA(C1=__builtin_amdgcn_mfma_f32_32x32x16_bf16(kf[5],qr[2],C1,0,0,0),   P1[6],P1[7],P1[8],P1[9],     pw2[2]=PKW(P1,4), pw2[3]=PKW(P1,6), pw2); \
    VRD(3); SBAR(); GAPA(C0=__builtin_amdgcn_mfma_f32_32x32x16_bf16(kf[6],qr[3],C0,0,0,0),   P1[10],P1[11],P1[12],P1[13], pw3[0]=PKW(P1,8), pw3[1]=PKW(P1,10), pw3); \
    VRD(7); SBAR(); GAPA(C1=__builtin_amdgcn_mfma_f32_32x32x16_bf16(kf[7],qr[3],C1,0,0,0),   P1[14],P1[15],0.f,0.f,       pw3[2]=PKW(P1,12),pw3[3]=PKW(P1,14), pw3); \
    l_reg+=sacc; \
    if(GK){DMA_K((t)+3,sl_cur);} if(GV){DMA_V((t)+1,sl_next);} \
    CMASK(C0,C1,t); \
    { float a=MX3(C0[0],C0[1],C1[0]),b=MX3(C0[2],C0[3],C1[1]); a=MX3(a,C1[2],C1[3]); \
      _Pragma("unroll") for(int r=4;r<16;r+=4){a=MX3(a,C0[r],C0[r+1]);b=MX3(b,C0[r+2],C0[r+3]);a=MX3(a,C1[r],C1[r+1]);b=MX3(b,C1[r+2],C1[r+3]);} \
      float rm=__builtin_fmaxf(a,b); rm=max_x32(rm); \
      resc=false; \
      if(__builtin_expect(__any(rm>(float)THRL),0)){ const float dl=__builtin_fmaxf(rm,0.f); mhat+=dl; \
        _Pragma("unroll") for(int r=0;r<16;++r){C0[r]-=dl;C1[r]-=dl;} \
        qx=make_qx(mhat,hi); \
        const float f=__builtin_amdgcn_exp2f(-dl); l_reg*=f; if(hi==0)wsf[r32]=f; resc=true; } } \
    SBAR(); \
    GAPB(o[0]=__builtin_amdgcn_mfma_f32_32x32x16_bf16(PAF(0),VFR(0),o[0],0,0,0), C0,0); \
    GAPB(o[1]=__builtin_amdgcn_mfma_f32_32x32x16_bf16(PAF(0),VFR(4),o[1],0,0,0), C0,4); \
    KRD(GL,0); GAPB(o[0]=__builtin_amdgcn_mfma_f32_32x32x16_bf16(PAF(1),VFR(1),o[0],0,0,0), C0,8); \
    KRD(GL,1); GAPB(o[1]=__builtin_amdgcn_mfma_f32_32x32x16_bf16(PAF(1),VFR(5),o[1],0,0,0), C0,12); \
    KRD(GL,2); GAPB(o[0]=__builtin_amdgcn_mfma_f32_32x32x16_bf16(PAF(2),VFR(2),o[0],0,0,0), C1,0); \
    KRD(GL,3); if(GL){ cload2(kc,cp0+(sl_next>>2)); SBAR(); } GAPB(o[1]=__builtin_amdgcn_mfma_f32_32x32x16_bf16(PAF(2),VFR(6),o[1],0,0,0), C1,4); \
    GAPB(o[0]=__builtin_amdgcn_mfma_f32_32x32x16_bf16(PAF(3),VFR(3),o[0],0,0,0), C1,8); \
    GAPB(o[1]=__builtin_amdgcn_mfma_f32_32x32x16_bf16(PAF(3),VFR(7),o[1],0,0,0), C1,12); \
    }while(0)
  int t=1;
  #undef CMASK
  #define CMASK(P0,P1,t) do{}while(0)
  for(;t+5<NT;t+=2){
    STEP(pB0,pB1,pA0,pA1,t,true,true,true);     WAIT_BAR(3); RESC(); ROT();
    STEP(pA0,pA1,pB0,pB1,t+1,true,true,true);   WAIT_BAR(3); RESC(); ROT();
  }
  #undef CMASK
  #define CMASK(P0,P1,t) do{int jb_=(t)-(NT-4); if(jb_>=0)cmask(P0,P1,jb_,qrel,hi);}while(0)
  #define ENDW(tt) do{ if((tt)+3<NT){WAIT_BAR(3);} else if((tt)+2<NT){WAIT_BAR(1);} else {WAIT_BAR(0);} }while(0)
  for(;t+1<NT;t+=2){
    STEP(pB0,pB1,pA0,pA1,t,(t+3<NT),(t+1<NT),(t+1<NT));       ENDW(t);   RESC(); ROT();
    STEP(pA0,pA1,pB0,pB1,t+1,(t+4<NT),(t+2<NT),(t+2<NT));     ENDW(t+1); RESC(); ROT();
  }
  STEP(pB0,pB1,pA0,pA1,NT-1,false,false,false); RESC();
  { float sacc=pB0[0]+pB0[1]; _Pragma("unroll") for(int r=2;r<16;++r)sacc+=pB0[r]; _Pragma("unroll") for(int r=0;r<16;++r)sacc+=pB1[r]; l_reg+=sacc;
    pw0=(u32x4){PKW(pB0,0),PKW(pB0,2),PKW(pB0,4),PKW(pB0,6)};pw1=(u32x4){PKW(pB0,8),PKW(pB0,10),PKW(pB0,12),PKW(pB0,14)};pw2=(u32x4){PKW(pB1,0),PKW(pB1,2),PKW(pB1,4),PKW(pB1,6)};pw3=(u32x4){PKW(pB1,8),PKW(pB1,10),PKW(pB1,12),PKW(pB1,14)};
    SBAR(); pv(o,vb0+sl_cur,PAF(0),PAF(1),PAF(2),PAF(3)); }
  #undef PKW
  #undef PAF
  #undef VFR
  #undef PIN
  #undef MX3
  #undef GAPA
  #undef GAPB
  #undef EX
  #undef VRD
  #undef KRD
  #undef STEP
  #undef ENDW
  l_reg=add_x32(l_reg);
  if(hi==0)wsf[32+r32]=l_reg;asm volatile("s_waitcnt lgkmcnt(0)":::"memory");
  float rli[16];
  #pragma unroll
  for(int r=0;r<16;++r)rli[r]=__builtin_amdgcn_rcpf(wsf[32+crow(r,hi)]);
  bf16*Ow=O+(rowbase+q0+wid*QBLK)*DM+h*D;
  { bf16*stg=(bf16*)(shm+LDS_OST)+wid*2048;
    #pragma unroll
    for(int r=0;r<16;++r){const int orow=crow(r,hi);
      #pragma unroll
      for(int d0=0;d0<2;++d0)stg[orow*64+d0*32+r32]=__float2bfloat16(o[d0][r]*rli[r]);}
    asm volatile("s_waitcnt lgkmcnt(0)":::"memory");
    const bf16*Gw=GT+(rowbase+q0+wid*QBLK)*DM+h*D;
    #pragma unroll
    for(int i=0;i<4;++i){const int row=i*8+(lane>>3),ch=lane&7; const u32x4 v=*(const u32x4*)(stg+row*64+ch*8); const u32x4 g=*(const u32x4*)(Gw+(long)row*DM+ch*8); u32x4 w;
      #define GM(a,b) cvtpk_s(__builtin_bit_cast(float,(a)<<16)*__builtin_bit_cast(float,(b)<<16),__builtin_bit_cast(float,(a)&0xffff0000u)*__builtin_bit_cast(float,(b)&0xffff0000u))
      w.x=GM(v.x,g.x);w.y=GM(v.y,g.y);w.z=GM(v.z,g.z);w.w=GM(v.w,g.w);
      #undef GM
      ATTN_STORE16(Ow+(long)row*DM+ch*8,w);} }
  asm volatile("s_waitcnt lgkmcnt(0)\n\ts_barrier":::"memory");
  #undef DMA_K
  #undef DMA_V
  #undef CMASK
  #undef START
  #undef RESC
  #undef ROT
}
constexpr int ATTN_LDS_BYTES=LDS_BYTES;
struct AttnTensors { const bf16* Q; const bf16* K; const bf16* V; const bf16* KC; const bf16* G; bf16* O; };
struct AttnUnit { int bh; int qb; };
struct StaticOrder {
  int vcu, G;
  __device__ __forceinline__ explicit StaticOrder(int grid,int block):vcu((grid%8==0)?(block%8)*(grid/8)+block/8:block),G(grid){}
  __device__ __forceinline__ bool next(int i,AttnUnit&u)const{ if(G!=256){ const int L=i*G+vcu; if(L>=BATCH*NHEAD*NQB)return false; u.bh=L/NQB; u.qb=L%NQB; return true; } if(i>=8)return false; const int s=vcu&7,j=i&3; u.bh=(vcu>>3)+32*(i>>2); u.qb=(j==0)?s:(j==1)?15-s:(j==2)?16+s:31-s; return true; }
  __device__ __forceinline__ void a_ready(const AttnUnit&)const{}
  __device__ __forceinline__ void done(const AttnUnit&)const{}
};
template<class Sched,int THRL=8> __device__ __forceinline__ void attn_phase(char*lds,int wave_s,const AttnTensors&T,const Sched&S){
  AttnUnit u;
  for(int i=0;S.next(i,u);++i){ S.a_ready(u); attn_unit<THRL>(wave_s,u.bh/NHEAD,u.bh%NHEAD,u.qb,T.Q,T.K,T.V,T.KC,T.G,T.O,lds); S.done(u); }
}
#undef SBAR
#undef WAIT_BAR
}

constexpr int N_PHASES = 1 + DEPTH * 12;
#ifndef MK_MASK
#define MK_MASK 0xFFFFFFFFu
#endif
#define EN(n) ((((unsigned)(MK_MASK)) >> (n)) & 1u)

#define PH_PTRS CArgs* A = args_ptr(); unsigned char* ws = A->ws; (void)ws; const Ctx F = make_ctx(lds_raw, wave_s)
#define WSP(T, off) ((T*)(ws + (off)))
#define PJ(i) (WSP(bf16, WS_PROJ) + (size_t)(i) * M * DM)

#define PH_IN(k) (lo <= (k) && (k) < hi)
#if MK_PER_PHASE
#define PH_SEAM(k) do { } while (0)
#else
#define PH_SEAM(k) do { if ((k) + 1 < hi) xcd_barrier(bar); } while (0)
#endif
template <int L> __device__ __forceinline__ void layer_body(unsigned char* lds_raw, const int lo, const int hi, const int wave_s, const XcdBarrier& bar, LAS int* tab) {
    constexpr int kind = L % 3, pb = 1 + L * 12, j = L / 3;
        if (PH_IN(pb + 0)) {
            { PH_PTRS; const float* Hsrc = (L == 0) ? A->in[I_X] : WSP(float, WS_H);
              if (EN(18) && kind == 1) t1_fox(F, Hsrc, A->in[I_NORM_MIX] + L * DM, WSP(bf16, WS_XN), A->in[I_FOX_WIN], A->in[I_FOX_FB], WSP(float, WS_LSIG));
              else if (EN(1)) t1_plain(F, Hsrc, A->in[I_NORM_MIX] + L * DM, WSP(bf16, WS_XN)); }
            if (EN(19)) { PH_PTRS; pg8::StaticOrder S; S.init(WSP(bf16, WS_PB) + (size_t)L * M * PLED, WSP(bf16, WS_W_PLE) + (size_t)L * DM * PLED, M, DM, PLED, PLED, F.G, F.bid);
              pg8::EpiPleA E{WSP(bf16, WS_PW), WSP(float, WS_PSS)};
              pg8::gemm_phase<pg8::EpiPleA, pg8::StaticOrder, true>(F.lds, F.wave, pg8::GemmD{PLED, PLED}, S, E); }
            PH_SEAM(pb + 0);
        }
        if (kind == 0) {
            if (EN(2) && PH_IN(pb + 1)) { PH_PTRS;
                pg8::StaticOrder S; S.init(WSP(bf16, WS_XN), WSP(bf16, WS_W_HGIN) + (size_t)j * 4096 * DM, M, 4096, DM, DM, F.G, F.bid);
                pg8::EpiHgIn E{PJ(0), PJ(1), PJ(2), PJ(3), WSP(float, WS_F32A), WSP(float, WS_SMALL) + (L == 0 ? SM_LB0 / 4 : SM_LB3 / 4)};
                pg8::gemm_phase<pg8::EpiHgIn, pg8::StaticOrder, true>(F.lds, F.wave, pg8::GemmD{DM, DM}, S, E);
                PH_SEAM(pb + 1);
            }
            if (EN(3) && PH_IN(pb + 2)) { PH_PTRS; for (int u = F.vcu; u < 4096; u += F.G) hg_unit_a(F, u, WSP(float, WS_F32A), PJ(1), PJ(2), WSP(float, WS_HGG), WSP(float, WS_HGDEC)); PH_SEAM(pb + 2); }
            if (EN(4) && PH_IN(pb + 3)) { PH_PTRS; hg_scan_b(F, WSP(float, WS_HGG), WSP(float, WS_HGDEC), WSP(bf16, WS_HGS)); PH_SEAM(pb + 3); }
            if (EN(5) && PH_IN(pb + 4)) { PH_PTRS; for (int u = F.vcu; u < 4096; u += F.G) hg_unit_c(F, u, WSP(float, WS_F32A), PJ(0), PJ(1), PJ(2), PJ(3), WSP(bf16, WS_HGS), A->in[I_HG_GNORM] + j * 128, WSP(bf16, WS_MIXO)); PH_SEAM(pb + 4); }
        } else if (kind == 1) {
            if (EN(6) && PH_IN(pb + 1)) {
                { PH_PTRS; fox_cum(F, WSP(float, WS_LSIG), WSP(float, WS_FCUM), WSP(bf16, WS_KC)); }
                { PH_PTRS; pg8::StaticOrder S; S.init(WSP(bf16, WS_XN), WSP(bf16, WS_W_FOXIN), M, 4096, DM, DM, F.G, F.bid);
                  pg8::EpiFoxIn E{PJ(0), PJ(1), PJ(2), PJ(3), A->in[I_FOX_QN], A->in[I_FOX_KN], attn_body::C2};
                  pg8::gemm_phase<pg8::EpiFoxIn, pg8::StaticOrder, true>(F.lds, F.wave, pg8::GemmD{DM, DM}, S, E); }
                PH_SEAM(pb + 1);
            }
            if (EN(7) && PH_IN(pb + 2)) { PH_PTRS;
                const attn_body::AttnTensors AT{(const attn_body::bf16*)PJ(0), (const attn_body::bf16*)PJ(1), (const attn_body::bf16*)PJ(2), (const attn_body::bf16*)WSP(bf16, WS_KC), (const attn_body::bf16*)PJ(3), (attn_body::bf16*)WSP(bf16, WS_MIXO)};
                const attn_body::StaticOrder S((int)F.G, (int)F.bid);
                attn_body::attn_phase<attn_body::StaticOrder>((char*)lds_raw, F.wave, AT, S);
                PH_SEAM(pb + 2);
            }
        } else {
            if (EN(8) && PH_IN(pb + 1)) { PH_PTRS;
                pg8::StaticOrder S; S.init(WSP(bf16, WS_XN), WSP(bf16, WS_W_RGIN), M, 2048, DM, DM, F.G, F.bid);
                pg8::EpiRgIn E{PJ(0), PJ(1)};
                pg8::gemm_phase<pg8::EpiRgIn, pg8::StaticOrder, true>(F.lds, F.wave, pg8::GemmD{DM, DM}, S, E);
                PH_SEAM(pb + 1);
            }
            if (EN(9) && PH_IN(pb + 2)) { PH_PTRS; rg_conv(F, PJ(1), A->in[I_RG_CW], A->in[I_RG_CB], PJ(2)); PH_SEAM(pb + 2); }
            if (EN(10) && PH_IN(pb + 3)) { PH_PTRS;
                pg8::StaticOrder S; S.init(PJ(2), WSP(bf16, WS_W_RGAX), M, 2048, 256, DM, F.G, F.bid, 1);
                pg8::EpiRgGate E{PJ(2), A->in[I_RG_BA], A->in[I_RG_BX], WSP(float, WS_SMALL) + SM_SP8 / 4, WSP(float, WS_F32A), WSP(float, WS_F32B)};
                pg8::gemm_phase<pg8::EpiRgGate, pg8::StaticOrder, true>(F.lds, F.wave, pg8::GemmD{256, DM}, S, E);
                PH_SEAM(pb + 3);
            }
            if (EN(11) && PH_IN(pb + 4)) { PH_PTRS; rg_scan1(F, WSP(float, WS_F32A), WSP(float, WS_F32B), WSP(float, WS_SCAN)); PH_SEAM(pb + 4); }
            if (EN(11) && PH_IN(pb + 5)) { PH_PTRS; rg_scan2(F, WSP(float, WS_F32A), WSP(float, WS_F32B), WSP(float, WS_SCAN), PJ(0), WSP(bf16, WS_MIXO)); PH_SEAM(pb + 5); }
        }
        if (EN(12) && PH_IN(pb + 6)) { PH_PTRS;
            const bf16* Wo = kind == 0 ? WSP(bf16, WS_W_HGOUT) + (size_t)j * DM * DM : kind == 1 ? WSP(bf16, WS_W_FOXOUT) : WSP(bf16, WS_W_RGOUT);
            pg8::StaticOrder S; S.init(WSP(bf16, WS_MIXO), Wo, M, DM, DM, DM, F.G, F.bid);
            pg8::EpiResid E{(L == 0) ? A->in[I_X] : WSP(float, WS_H), WSP(float, WS_H)};
            pg8::gemm_phase<pg8::EpiResid, pg8::StaticOrder, true>(F.lds, F.wave, pg8::GemmD{DM, DM}, S, E);
            PH_SEAM(pb + 6);
        }
        if (EN(13) && PH_IN(pb + 7)) { PH_PTRS;
            t2_router(F, WSP(float, WS_H), A->in[I_NORM_FFN] + L * DM, WSP(bf16, WS_XN), A->in[I_RT_W] + (size_t)L * DM * NEXP, A->in[I_RT_B] + L * NEXP, (gu32*)(ws + WS_CTL) + CW_CNT + L * 32, WSP(unsigned, WS_LENT), WSP(float, WS_LGATE));
            PH_SEAM(pb + 7);
        }
        if (PH_IN(pb + 8) || PH_IN(pb + 9)) { PH_PTRS;
            __syncthreads();
            if (F.tid < 32) tab[40 + F.tid] = (int)__hip_atomic_load((gu32*)(ws + WS_CTL) + CW_CNT + L * 32 + F.tid, RLX_AGENT);
            __syncthreads();
            if (F.tid == 0) { int s = 0; for (int e = 0; e < 32; ++e) { tab[e] = s; s += (tab[40 + e] + 255) >> 8; } tab[32] = s; }
            __syncthreads();
        }
        if (EN(14) && PH_IN(pb + 8)) { PH_PTRS;
            pg8::MoeOrder<true, 3> S; S.tab = tab; S.G = F.G; S.vcu = F.vcu; S.total = __builtin_amdgcn_readfirstlane(tab[32]) << 3; S.A = (const char*)WSP(bf16, WS_XN); S.B = (const char*)(ws + WS_W_GU) + (size_t)L * 32 * 2048 * DM * 2;
            S.b_estride = (size_t)2048 * DM * 2; S.K = DM; S.lda = DM; S.lent = WSP(unsigned, WS_LENT);
            pg8::EpiMoeGU E{WSP(bf16, WS_ACT), A->in[I_GU_B] + (size_t)L * 32 * 2048};
            pg8::gemm_phase<pg8::EpiMoeGU, pg8::MoeOrder<true, 3>, true>(F.lds, F.wave, pg8::GemmD{DM, DM}, S, E);
            PH_SEAM(pb + 8);
        }
        if (EN(15) && PH_IN(pb + 9)) { PH_PTRS;
            pg8::MoeOrder<false, 2> S; S.tab = tab; S.G = F.G; S.vcu = F.vcu; S.total = __builtin_amdgcn_readfirstlane(tab[32]) << 2; S.A = (const char*)(ws + WS_ACT); S.B = (const char*)(ws + WS_W_DN) + (size_t)L * 32 * DM * DM * 2;
            S.b_estride = (size_t)DM * DM * 2; S.K = DM; S.lda = DM; S.lent = WSP(unsigned, WS_LENT);
            pg8::EpiMoeDN E{WSP(bf16, WS_Y), A->in[I_DN_B] + (size_t)L * 32 * DM, WSP(unsigned, WS_LENT), WSP(float, WS_LGATE), tab};
            pg8::gemm_phase<pg8::EpiMoeDN, pg8::MoeOrder<false, 2>, true>(F.lds, F.wave, pg8::GemmD{DM, DM}, S, E);
            PH_SEAM(pb + 9);
        }
        if (EN(16) && PH_IN(pb + 10)) { PH_PTRS; t3_combine(F, WSP(float, WS_H), WSP(bf16, WS_Y), A->in[I_PLE_GN] + L * DM, WSP(bf16, WS_GN), WSP(float, WS_PSS), WSP(float, WS_PRSTD)); PH_SEAM(pb + 10); }
        if (EN(17) && PH_IN(pb + 11)) { PH_PTRS;
            pg8::StaticOrder S; S.init(WSP(bf16, WS_GN), WSP(bf16, WS_W_PLEG) + (size_t)L * DM * DM, M, DM, DM, DM, F.G, F.bid);
            pg8::EpiPleFin E{WSP(float, WS_H), (L == DEPTH - 1) ? A->out : WSP(float, WS_H), WSP(bf16, WS_PW), WSP(float, WS_PRSTD), A->in[I_PLE_N] + L * DM};
            pg8::gemm_phase<pg8::EpiPleFin, pg8::StaticOrder, true>(F.lds, F.wave, pg8::GemmD{DM, DM}, S, E);
            PH_SEAM(pb + 11);
        }
}

__global__ void __launch_bounds__(NTHR, 2) mk_fwd(Args args) {
    extern __shared__ __attribute__((aligned(16))) unsigned char lds_raw[];
    volatile LAS unsigned* MISC = (volatile LAS unsigned*)((LAS unsigned char*)lds_raw + MISC_OFF);
    if (threadIdx.x < 32) MISC[threadIdx.x] = 0u;
    __syncthreads();
    XcdBarrier bar; bar.bar = (unsigned*)(args.ws + WS_CTL) + CW_BAR; bar.x = 0; bar.st = nullptr;
#if !MK_PER_PHASE
    bar = xcd_barrier_post((unsigned*)(args.ws + WS_CTL) + CW_BAR, MISC + 8);
#endif
    const int lo = args.lo, hi = args.hi;
    const int wave_s = __builtin_amdgcn_readfirstlane((int)threadIdx.x >> 6);
    LAS int* tab = (LAS int*)((LAS unsigned char*)lds_raw + LDSX_OFF + 8192);

    if (EN(0) && PH_IN(0)) { PH_PTRS; p0_prologue(F, A); PH_SEAM(0); }

    layer_body<0>(lds_raw, lo, hi, wave_s, bar, tab); layer_body<1>(lds_raw, lo, hi, wave_s, bar, tab); layer_body<2>(lds_raw, lo, hi, wave_s, bar, tab); layer_body<3>(lds_raw, lo, hi, wave_s, bar, tab);
#undef PH_IN
#undef PH_SEAM
}

extern "C" void kernel_launch(void* const* d_in, const int* in_sizes, int n_in, void* d_out, int out_size, void* d_ws, size_t ws_size, hipStream_t stream) {
    static int grid = 0;
    if (grid == 0) {
        if (n_in != N_IN || out_size != M * DM || ws_size < WS_END) { fprintf(stderr, "kernel_launch: unexpected shapes (n_in %d, out %d, ws %zu)\n", n_in, out_size, ws_size); grid = -1; return; }
        int dev = 0, cus = 0, per_cu = 0;
        if (hipGetDevice(&dev) != hipSuccess || hipDeviceGetAttribute(&cus, hipDeviceAttributeMultiprocessorCount, dev) != hipSuccess) { grid = -1; return; }
        if (hipFuncSetAttribute((const void*)mk_fwd, hipFuncAttributeMaxDynamicSharedMemorySize, LDS_BYTES) != hipSuccess) { fprintf(stderr, "kernel_launch: hipFuncSetAttribute failed\n"); grid = -1; return; }
        if (hipOccupancyMaxActiveBlocksPerMultiprocessor(&per_cu, (const void*)mk_fwd, NTHR, LDS_BYTES) != hipSuccess || per_cu < 1) { fprintf(stderr, "kernel_launch: occupancy query says %d blocks per CU\n", per_cu); }
        (void)hipGetLastError();
        grid = cus;
    }
    if (grid < 0) return;
    (void)hipMemsetAsync((char*)d_ws + WS_CTL, 0, CTL_ZERO_BYTES, stream);
    Args a{};
    for (int i = 0; i < N_IN; ++i) a.in[i] = (const float*)d_in[i];
    a.out = (float*)d_out; a.ws = (unsigned char*)d_ws;
#if MK_PER_PHASE
    for (int k = 0; k < N_PHASES; ++k) {
        if (k > 0) { const int L = (k - 1) / 12, p = (k - 1) % 12, kind = L % 3; if ((kind == 1 && (p == 3 || p == 4 || p == 5)) || (kind == 0 && p == 5)) continue; }
        a.lo = k; a.hi = k + 1;
        hipLaunchKernelGGL(mk_fwd, dim3(grid), dim3(NTHR), LDS_BYTES, stream, a);
#if defined(MK_DEBUG) && MK_DEBUG
        hipLaunchKernelGGL(mk_chk, dim3(64), dim3(256), 0, stream, a, k);
#endif
    }
#if defined(MK_DEBUG) && MK_DEBUG
    hipLaunchKernelGGL(mk_encode, dim3(1024), dim3(256), 0, stream, a, MK_DEBUG - 1);
#endif
#else
    a.lo = 0; a.hi = N_PHASES;
    hipLaunchKernelGGL(mk_fwd, dim3(grid), dim3(NTHR), LDS_BYTES, stream, a);
#endif
}
```
